# Optimizing an MI355X kernel written in HIP

```python
import jax
import jax.numpy as jnp
from jax import lax
import numpy as np

D_MODEL = 1024
BATCH = 8
SEQ = 2048
DEPTH = 4

N_MEM = 256
EPS = 1e-6
NEG_INF = -1e30

HEAD_DIM = 64
ROPE_DIM = HEAD_DIM // 4
ROPE_THETA = 500000.0

A_HEADS = 8
A_WIDTH = A_HEADS * HEAD_DIM
MOBA_BLOCK = 256
MOBA_TOPK = 3
MOBA_QCHUNK = 32

B_GROUPS = 8
B_WIDTH = B_GROUPS * HEAD_DIM
GMLP_CHUNK = 128

GLA_HEADS = 4
GLA_DK = (D_MODEL // 2) // GLA_HEADS
GLA_DV = D_MODEL // GLA_HEADS
GLA_LOWRANK = 16
GLA_TAU = 16.0
GLA_CHUNK = 64

X_HEADS = 4
X_HEAD_DIM = D_MODEL // X_HEADS

D_FF = -(-8 * D_MODEL // (3 * 256)) * 256

EV_IN = 3 * A_WIDTH + 2 * B_WIDTH
OD_IN = 2 * GLA_HEADS * GLA_DK + 2 * GLA_HEADS * GLA_DV

kernel_name = 'hybrid_moba_gmlp_gla_trunk'


def rmsnorm(x, g):
    xf = x.astype(jnp.float32)
    y = xf * lax.rsqrt(jnp.mean(xf * xf, axis=-1, keepdims=True) + EPS)
    return (y * g.astype(jnp.float32)).astype(x.dtype)


def layernorm(x, g, b):
    xf = x.astype(jnp.float32)
    mu = jnp.mean(xf, axis=-1, keepdims=True)
    var = jnp.mean(jnp.square(xf - mu), axis=-1, keepdims=True)
    y = (xf - mu) * lax.rsqrt(var + EPS) * g.astype(jnp.float32) + b.astype(jnp.float32)
    return y.astype(x.dtype)


def partial_rope(x, positions):
    half = ROPE_DIM // 2
    inv_freq = ROPE_THETA ** (-jnp.arange(half, dtype=jnp.float32) * 2.0 / ROPE_DIM)
    ang = positions.astype(jnp.float32)[:, None, :, None] * inv_freq
    cos, sin = jnp.cos(ang), jnp.sin(ang)
    xf = x.astype(jnp.float32)
    x1, x2 = xf[..., :half], xf[..., half:ROPE_DIM]
    out = jnp.concatenate([x1 * cos - x2 * sin, x2 * cos + x1 * sin, xf[..., ROPE_DIM:]], axis=-1)
    return out.astype(x.dtype)


def moba_attention(q, k, v):
    Bn, H, S, Dh = q.shape
    S_pad = -(-S // MOBA_BLOCK) * MOBA_BLOCK
    pad = [(0, 0), (0, 0), (0, S_pad - S), (0, 0)]
    q, k, v = jnp.pad(q, pad), jnp.pad(k, pad), jnp.pad(v, pad)
    nb = S_pad // MOBA_BLOCK
    topk = min(MOBA_TOPK, nb)
    scale = Dh ** -0.5
    kb = k.reshape(Bn, H, nb, MOBA_BLOCK, Dh)
    vb = v.reshape(Bn, H, nb, MOBA_BLOCK, Dh)
    k_mean = jnp.mean(kb.astype(jnp.float32), axis=3)
    gate = jnp.einsum('bhsd,bhnd->bhsn', q.astype(jnp.float32), k_mean)
    own = jnp.arange(S_pad) // MOBA_BLOCK
    past = jnp.arange(nb)[None, :] < own[:, None]
    gate = jnp.where(past[None, None], gate, NEG_INF)
    _, sel = lax.top_k(gate, topk)
    valid = sel < own[None, None, :, None]

    nq = S_pad // MOBA_QCHUNK
    q_c = q.reshape(Bn, H, nq, MOBA_QCHUNK, Dh).transpose(2, 0, 1, 3, 4)
    sel_c = sel.reshape(Bn, H, nq, MOBA_QCHUNK, topk).transpose(2, 0, 1, 3, 4)
    valid_c = valid.reshape(Bn, H, nq, MOBA_QCHUNK, topk).transpose(2, 0, 1, 3, 4)
    chunk_ids = jnp.arange(nq, dtype=jnp.int32)
    bi = jnp.arange(Bn)[:, None, None, None]
    hi = jnp.arange(H)[None, :, None, None]
    key_idx = jnp.arange(MOBA_BLOCK)

    def one_chunk(args):
        qc, selc, validc, ci = args
        blk = (ci * MOBA_QCHUNK) // MOBA_BLOCK
        k_own = lax.dynamic_index_in_dim(kb, blk, axis=2, keepdims=False)
        v_own = lax.dynamic_index_in_dim(vb, blk, axis=2, keepdims=False)
        qpos = (ci * MOBA_QCHUNK) % MOBA_BLOCK + jnp.arange(MOBA_QCHUNK)
        causal = key_idx[None, :] <= qpos[:, None]
        s_own = jnp.einsum('bhqd,bhkd->bhqk', qc, k_own, preferred_element_type=jnp.float32) * scale
        s_own = jnp.where(causal[None, None], s_own, NEG_INF)
        k_sel = kb[bi, hi, selc]
        v_sel = vb[bi, hi, selc]
        s_sel = jnp.einsum('bhqd,bhqnkd->bhqnk', qc, k_sel, preferred_element_type=jnp.float32) * scale
        s_sel = jnp.where(validc[..., None], s_sel, NEG_INF)
        logits = jnp.concatenate([s_own, s_sel.reshape(Bn, H, MOBA_QCHUNK, topk * MOBA_BLOCK)], axis=-1)
        p = jax.nn.softmax(logits, axis=-1)
        p_own = p[..., :MOBA_BLOCK].astype(v.dtype)
        p_sel = p[..., MOBA_BLOCK:].reshape(Bn, H, MOBA_QCHUNK, topk, MOBA_BLOCK).astype(v.dtype)
        out = (jnp.einsum('bhqk,bhkd->bhqd', p_own, v_own, preferred_element_type=jnp.float32)
               + jnp.einsum('bhqnk,bhqnkd->bhqd', p_sel, v_sel, preferred_element_type=jnp.float32))
        return out.astype(q.dtype)

    out = lax.map(one_chunk, (q_c, sel_c, valid_c, chunk_ids))
    out = out.transpose(1, 2, 0, 3, 4).reshape(Bn, H, S_pad, Dh)
    return out[:, :, :S]


def chunked_spatial_gating(u, v, w_s, b_s, ln_g, ln_b):
    Bn, S, G, Dg = v.shape
    nc = S // GMLP_CHUNK
    vn = layernorm(v, ln_g, ln_b).reshape(Bn, nc, GMLP_CHUNK, G, Dg)
    mask = jnp.tril(jnp.ones((GMLP_CHUNK, GMLP_CHUNK), dtype=w_s.dtype))
    ws = w_s * mask[None]
    mixed = jnp.einsum('gij,bcjgd->bcigd', ws, vn) + b_s.T[None, None, :, :, None]
    return u * mixed.reshape(Bn, S, G, Dg).astype(u.dtype)


def even_mixer(h, positions, w_in, q_gain, k_gain, w_s, b_s, ln_g, ln_b, w_out):
    Bn, S, _ = h.shape
    proj = h @ w_in
    q, k, v, pu, pv = jnp.split(proj, [A_WIDTH, 2 * A_WIDTH, 3 * A_WIDTH, 3 * A_WIDTH + B_WIDTH], axis=-1)

    def heads(t):
        return t.reshape(Bn, S, A_HEADS, HEAD_DIM).transpose(0, 2, 1, 3)

    q = partial_rope(rmsnorm(heads(q), q_gain), positions)
    k = partial_rope(rmsnorm(heads(k), k_gain), positions)
    a = moba_attention(q, k, heads(v)).transpose(0, 2, 1, 3).reshape(Bn, S, A_WIDTH)
    u = jax.nn.gelu(pu, approximate=False).reshape(Bn, S, B_GROUPS, HEAD_DIM)
    vg = jax.nn.gelu(pv, approximate=False).reshape(Bn, S, B_GROUPS, HEAD_DIM)
    g = chunked_spatial_gating(u, vg, w_s, b_s, ln_g, ln_b).reshape(Bn, S, B_WIDTH)
    return jnp.concatenate([a, g], axis=-1) @ w_out


def gla_chunked(q, k, v, log_a):
    Bn, H, S, dk = q.shape
    dv = v.shape[-1]
    nc = S // GLA_CHUNK
    f32 = jnp.float32
    qc = q.astype(f32).reshape(Bn, H, nc, GLA_CHUNK, dk)
    kc = k.astype(f32).reshape(Bn, H, nc, GLA_CHUNK, dk)
    vc = v.astype(f32).reshape(Bn, H, nc, GLA_CHUNK, dv)
    b = jnp.cumsum(log_a.astype(f32).reshape(Bn, H, nc, GLA_CHUNK, dk), axis=3)
    b_last = b[:, :, :, -1:, :]
    q_in = qc * jnp.exp(b)
    k_in = kc * jnp.exp(-b)
    causal = jnp.tril(jnp.ones((GLA_CHUNK, GLA_CHUNK), dtype=bool))
    att = jnp.where(causal, jnp.einsum('bhnid,bhnjd->bhnij', q_in, k_in), 0.0)
    o_intra = jnp.einsum('bhnij,bhnjv->bhniv', att, vc)
    k_state = kc * jnp.exp(b_last - b)
    d_state = jnp.einsum('bhnjd,bhnjv->bhndv', k_state, vc)
    decay = jnp.exp(b_last[:, :, :, 0, :])

    def step(s_prev, xs):
        ds_n, dec_n = xs
        return dec_n[..., None] * s_prev + ds_n, s_prev

    _, s_before = lax.scan(step, jnp.zeros((Bn, H, dk, dv), f32),
                           (jnp.moveaxis(d_state, 2, 0), jnp.moveaxis(decay, 2, 0)))
    s_before = jnp.moveaxis(s_before, 0, 2)
    o_inter = jnp.einsum('bhnid,bhndv->bhniv', q_in, s_before)
    return (o_intra + o_inter).reshape(Bn, H, S, dv).astype(v.dtype)


def gla_mixer(h, w_in, w_g1, w_g2, b_g, o_gain, w_out):
    Bn, S, _ = h.shape
    qk_w = GLA_HEADS * GLA_DK
    v_w = GLA_HEADS * GLA_DV
    proj = h @ w_in
    q, k, v, r = jnp.split(proj, [qk_w, 2 * qk_w, 2 * qk_w + v_w], axis=-1)
    log_a = jax.nn.log_sigmoid(((h @ w_g1) @ w_g2 + b_g).astype(jnp.float32)) / GLA_TAU

    def heads(t, d):
        return t.reshape(Bn, S, GLA_HEADS, d).transpose(0, 2, 1, 3)

    o = gla_chunked(heads(q, GLA_DK) * (GLA_DK ** -0.5), heads(k, GLA_DK),
                    heads(v, GLA_DV), heads(log_a, GLA_DK))
    o = rmsnorm(o, o_gain[:, None, :])
    o = o.transpose(0, 2, 1, 3).reshape(Bn, S, v_w) * jax.nn.silu(r)
    return o @ w_out


def mem_cross_attention(h, mem_n, w_q, w_kv, q_gain, k_gain, w_out):
    Bn, S, _ = h.shape
    M = mem_n.shape[1]
    q = rmsnorm((h @ w_q).reshape(Bn, S, X_HEADS, X_HEAD_DIM), q_gain)
    k, v = jnp.split(mem_n @ w_kv, 2, axis=-1)
    k = rmsnorm(k.reshape(Bn, M, X_HEADS, X_HEAD_DIM), k_gain)
    v = v.reshape(Bn, M, X_HEADS, X_HEAD_DIM)
    s = jnp.einsum('bqhd,bkhd->bhqk', q, k, preferred_element_type=jnp.float32) * (X_HEAD_DIM ** -0.5)
    p = jax.nn.softmax(s, axis=-1).astype(v.dtype)
    o = jnp.einsum('bhqk,bkhd->bqhd', p, v).reshape(Bn, S, D_MODEL)
    return o @ w_out


def swiglu(h, w_gu, w_down):
    g, u = jnp.split(h @ w_gu, 2, axis=-1)
    return (jax.nn.silu(g) * u) @ w_down


def setup_inputs(seed: int = 0) -> dict:
    key = jax.random.key(seed)
    ks = iter(jax.random.split(key, 32))
    f32 = jnp.float32
    n_ev = (DEPTH + 1) // 2
    n_od = DEPTH // 2

    def nrm(shape, scale):
        return jax.random.normal(next(ks), shape, f32) * scale

    def gain(shape):
        return 1.0 + 0.05 * jax.random.normal(next(ks), shape, f32)

    x = nrm((BATCH, SEQ, D_MODEL), 1.0)
    mem = nrm((BATCH, N_MEM, D_MODEL), 1.0)
    positions = (jnp.arange(SEQ, dtype=jnp.int32)[None, :]
                 + jax.random.randint(next(ks), (BATCH, 1), 0, 4096, dtype=jnp.int32))
    return {
        'x': x,
        'mem': mem,
        'positions': positions,
        'norm_mix': gain((DEPTH, D_MODEL)),
        'norm_mem_q': gain((DEPTH, D_MODEL)),
        'norm_mem_kv': gain((DEPTH, D_MODEL)),
        'norm_ffn': gain((DEPTH, D_MODEL)),
        'ev_w_in': nrm((n_ev, D_MODEL, EV_IN), D_MODEL ** -0.5),
        'ev_q_gain': gain((n_ev, HEAD_DIM)),
        'ev_k_gain': gain((n_ev, HEAD_DIM)),
        'ev_w_s': nrm((n_ev, B_GROUPS, GMLP_CHUNK, GMLP_CHUNK), GMLP_CHUNK ** -0.5),
        'ev_b_s': gain((n_ev, B_GROUPS, GMLP_CHUNK)),
        'ev_ln_g': gain((n_ev, B_GROUPS, HEAD_DIM)),
        'ev_ln_b': nrm((n_ev, B_GROUPS, HEAD_DIM), 0.02),
        'ev_w_out': nrm((n_ev, A_WIDTH + B_WIDTH, D_MODEL), 0.5 * (A_WIDTH + B_WIDTH) ** -0.5),
        'od_w_in': nrm((n_od, D_MODEL, OD_IN), D_MODEL ** -0.5),
        'od_w_g1': nrm((n_od, D_MODEL, GLA_LOWRANK), D_MODEL ** -0.5),
        'od_w_g2': nrm((n_od, GLA_LOWRANK, GLA_HEADS * GLA_DK), GLA_LOWRANK ** -0.5),
        'od_b_g': nrm((n_od, GLA_HEADS * GLA_DK), 0.02),
        'od_o_gain': gain((n_od, GLA_HEADS, GLA_DV)),
        'od_w_out': nrm((n_od, GLA_HEADS * GLA_DV, D_MODEL), 0.5 * (GLA_HEADS * GLA_DV) ** -0.5),
        'xa_w_q': nrm((DEPTH, D_MODEL, D_MODEL), D_MODEL ** -0.5),
        'xa_w_kv': nrm((DEPTH, D_MODEL, 2 * D_MODEL), D_MODEL ** -0.5),
        'xa_q_gain': gain((DEPTH, X_HEAD_DIM)),
        'xa_k_gain': gain((DEPTH, X_HEAD_DIM)),
        'xa_w_out': nrm((DEPTH, D_MODEL, D_MODEL), 0.5 * D_MODEL ** -0.5),
        'ffn_w_gu': nrm((DEPTH, D_MODEL, 2 * D_FF), D_MODEL ** -0.5),
        'ffn_w_down': nrm((DEPTH, D_FF, D_MODEL), 0.5 * D_FF ** -0.5),
    }


def reference(x, mem, positions, norm_mix, norm_mem_q, norm_mem_kv, norm_ffn,
              ev_w_in, ev_q_gain, ev_k_gain, ev_w_s, ev_b_s, ev_ln_g, ev_ln_b, ev_w_out,
              od_w_in, od_w_g1, od_w_g2, od_b_g, od_o_gain, od_w_out,
              xa_w_q, xa_w_kv, xa_q_gain, xa_k_gain, xa_w_out,
              ffn_w_gu, ffn_w_down):
    for l in range(DEPTH):
        i = l // 2
        h = rmsnorm(x, norm_mix[l])
        if l % 2 == 0:
            x = x + even_mixer(h, positions, ev_w_in[i], ev_q_gain[i], ev_k_gain[i],
                               ev_w_s[i], ev_b_s[i], ev_ln_g[i], ev_ln_b[i], ev_w_out[i])
        else:
            x = x + gla_mixer(h, od_w_in[i], od_w_g1[i], od_w_g2[i], od_b_g[i],
                              od_o_gain[i], od_w_out[i])
        x = x + mem_cross_attention(rmsnorm(x, norm_mem_q[l]), rmsnorm(mem, norm_mem_kv[l]),
                                    xa_w_q[l], xa_w_kv[l], xa_q_gain[l], xa_k_gain[l], xa_w_out[l])
        x = x + swiglu(rmsnorm(x, norm_ffn[l]), ffn_w_gu[l], ffn_w_down[l])
    return x
```

```cpp
#include <hip/hip_runtime.h>
#include <cstdio>
#include <cstdint>

namespace pg8 {
#define PG8_LAS __attribute__((address_space(3)))
typedef unsigned short bf16_t;
typedef short bf16x8 __attribute__((ext_vector_type(8)));
typedef float f32x4 __attribute__((ext_vector_type(4)));
typedef float f32x2 __attribute__((ext_vector_type(2)));
typedef unsigned u32x4 __attribute__((ext_vector_type(4)));
constexpr int BM = 256, BK = 64, HALF = 128, HTB = HALF * BK * 2, STAGE_BYTES = 8 * HTB, NXCD = 8, WGM = 8;

__host__ __device__ __forceinline__ int lds_byte(int r, int c) { const int st = (r >> 4) * 2 + (c >> 5), rr = r & 15, cc = c & 31, ob = rr * 64 + cc * 2; return st * 1024 + (ob ^ (((ob >> 9) & 1) << 5)); }
__host__ __device__ __forceinline__ void stage_rc(int b, int& R, int& C) { const int st = b / 1024, sb = b % 1024, swz = sb ^ (((sb >> 9) & 1) << 5); R = (st >> 1) * 16 + swz / 64; C = (st & 1) * 32 + (swz % 64) / 2; }
__host__ __device__ __forceinline__ int perm32(int rho) { const int n = rho >> 4, i = rho & 15; return 8 * (i >> 2) + 4 * n + (i & 3); }

struct Unit { int pm, pn; };
struct Gemm { const bf16_t* A; const bf16_t* Bt; int M, N, K; int bTile, bHalf, bGrp; int aTileMod; size_t bBatchBytes; unsigned long long pnmap; };
__host__ __device__ __forceinline__ int pn_logical(unsigned long long map, int pn) { return pn < 16 ? (int)((map >> (4 * pn)) & 15ull) : pn; }

struct StaticOrder {
    int nM, nN, nwg, G, c;
    __host__ __device__ void init(int M, int N, int G_, int c_) { nM = M / BM; nN = N / BM; nwg = nM * nN; G = G_; c = c_; }
    __host__ __device__ bool next(int i, Unit& u) const {
        const long L = (long)i * G + c; if (L >= nwg) return false;
        int wgid = (int)L; { const int q = nwg / NXCD, r = nwg % NXCD, xcd = wgid % NXCD, off = wgid / NXCD; wgid = (xcd < r ? xcd * (q + 1) : r * (q + 1) + (xcd - r) * q) + off; }
        const int nig = WGM * nN, gid = wgid / nig, fm = gid * WGM, gsz = (nM - fm) < WGM ? (nM - fm) : WGM;
        u.pm = fm + ((wgid % nig) % gsz); u.pn = (wgid % nig) / gsz; return true;
    }
};

struct MemKVOrder {
    int first, step, lbase;
    __host__ __device__ bool next(int i, Unit& u) const { const int idx = first + i * step; if (idx >= 128) return false; const int j = idx >> 3; u.pm = (lbase + (j >> 3)) * 8 + (idx & 7); u.pn = j & 7; return true; }
};

typedef __bf16 bf16x2_t __attribute__((ext_vector_type(2)));
__device__ __forceinline__ unsigned cvt_pk_bf16(float lo, float hi) { const f32x2 v = {lo, hi}; const bf16x2_t b = __builtin_convertvector(v, bf16x2_t); return __builtin_bit_cast(unsigned, b); }
typedef _Float16 half2_t __attribute__((ext_vector_type(2)));
typedef _Float16 half8_t __attribute__((ext_vector_type(8)));
__device__ __forceinline__ unsigned cvt_pk_f16(float lo, float hi) { const f32x2 v = {lo, hi}; const half2_t h = __builtin_convertvector(v, half2_t); return __builtin_bit_cast(unsigned, h); }
__device__ __forceinline__ f32x2 unpk_f16(unsigned w) { const half2_t h = __builtin_bit_cast(half2_t, w); return __builtin_convertvector(h, f32x2); }
__device__ __forceinline__ f32x2 gelu_pk(f32x2 v) {
    const f32x2 av = __builtin_elementwise_abs(v), d = av * 0.2316418882f + 1.0f;
    f32x2 t; t.x = __builtin_amdgcn_rcpf(d.x); t.y = __builtin_amdgcn_rcpf(d.y);
    f32x2 q = t * 0.5307027145f + (-0.7265760135f); q = q * t + 0.7107068705f; q = q * t + (-0.142248368f); q = q * t + 0.127414796f; q = q * t;
    const f32x2 s = (v * v) * (-0.72134752044f);
    f32x2 e; e.x = __builtin_amdgcn_exp2f(s.x); e.y = __builtin_amdgcn_exp2f(s.y);
    const f32x2 m = v * (q * e), r = v - m;
    f32x2 o; o.x = v.x < 0.f ? m.x : r.x; o.y = v.y < 0.f ? m.y : r.y; return o;
}
__device__ __forceinline__ float row_rstd(const float* SS, int row) {
    const f32x4* p = (const f32x4*)(SS + (unsigned)row * 16u); const f32x4 a = p[0], b = p[1], c = p[2], d = p[3];
    const float s = ((a[0] + a[1]) + (a[2] + a[3])) + ((b[0] + b[1]) + (b[2] + b[3])) + ((c[0] + c[1]) + (c[2] + c[3])) + ((d[0] + d[1]) + (d[2] + d[3]));
    return __builtin_amdgcn_rsqf(s * (1.0f / 1024.0f) + 1e-6f);
}
constexpr int EV_ROPE_TAB = 131072, EV_GAIN_TAB = 131072 + 8192 + 2048;
constexpr int RSTD_TAB = 131072 + 8192;
__device__ __forceinline__ void rstd8(float (&rs)[2][4], PG8_LAS unsigned char* lds, const float* SS, int upm, int wr, int fr) {
    const PG8_LAS float* tab = (const PG8_LAS float*)(lds + RSTD_TAB);
    if (*(const PG8_LAS int*)(lds + RSTD_TAB + 1024) == upm) {
#pragma unroll
        for (int ai = 0; ai < 2; ++ai)
#pragma unroll
            for (int m = 0; m < 4; ++m) rs[ai][m] = tab[ai * HALF + wr * 64 + m * 16 + fr];
    } else {
#pragma unroll
        for (int ai = 0; ai < 2; ++ai)
#pragma unroll
            for (int m = 0; m < 4; ++m) { rs[ai][m] = row_rstd(SS, upm * BM + ai * HALF + wr * 64 + m * 16 + fr); if (m & 1) asm volatile("" ::: "memory"); }
    }
}
__device__ __forceinline__ u32x4 pack8(const float* v) { u32x4 w; w.x = cvt_pk_bf16(v[0], v[1]); w.y = cvt_pk_bf16(v[2], v[3]); w.z = cvt_pk_bf16(v[4], v[5]); w.w = cvt_pk_bf16(v[6], v[7]); return w; }


struct EpiStore {
    bf16_t* O; int ldc; const float* SS; int ssMask; int scols; float cscale;
    __device__ __forceinline__ void operator()(const f32x4 (&acc)[2][2][4][2], const Unit& u, int wr, int wc, int fr, int fq, PG8_LAS unsigned char* lds) const {
        const int c0 = u.pn * BM + wc * 64 + 8 * fq;
        float rsv[2][4]; rstd8(rsv, lds, SS, u.pm, wr, fr);
#pragma unroll
        for (int ai = 0; ai < 2; ++ai)
#pragma unroll
            for (int m = 0; m < 4; ++m) {
                const int row = u.pm * BM + ai * HALF + wr * 64 + m * 16 + fr;
                const float rs = rsv[ai][m];
#pragma unroll
                for (int bj = 0; bj < 2; ++bj) {
                    const int col = c0 + 32 * bj; const float sc = rs * (col < scols ? cscale : 1.0f);
                    float v[8];
#pragma unroll
                    for (int n = 0; n < 2; ++n)
#pragma unroll
                        for (int e = 0; e < 4; ++e) v[4 * n + e] = acc[ai][bj][m][n][e] * sc;
                    *(u32x4*)(O + ((unsigned)row * (unsigned)ldc + (unsigned)col)) = pack8(v);
                }
            }
    }
};
struct EpiMemKV {
    bf16_t* KXN; bf16_t* VX; const float* SSM; const float* kg; const float* qg; PG8_LAS float* P;
    __device__ __forceinline__ void operator()(const f32x4 (&acc)[2][2][4][2], const Unit& u, int wr, int wc, int fr, int fq, PG8_LAS unsigned char* lds) const {
        asm volatile("" : "+v"(fr), "+v"(fq));
        const int lyr = u.pm >> 3; const bool isk = u.pn < 4; const int head = u.pn & 3;
        float rsv[2][4], gk[2][8];
        if (*(const PG8_LAS int*)(lds + RSTD_TAB + 1024) != 0x1000 + u.pm) {
            __syncthreads();
            const int tid = (wr * 4 + wc) * 64 + fq * 16 + fr;
            if (tid < 256) ((PG8_LAS float*)(lds + RSTD_TAB))[tid] = row_rstd(SSM, (u.pm * BM + tid) & 2047);
            if (tid == 0) *(PG8_LAS int*)(lds + RSTD_TAB + 1024) = 0x1000 + u.pm;
            __syncthreads();
        }
        { const PG8_LAS float* tab = (const PG8_LAS float*)(lds + RSTD_TAB);
#pragma unroll
          for (int ai = 0; ai < 2; ++ai)
#pragma unroll
            for (int m = 0; m < 4; ++m) rsv[ai][m] = tab[ai * HALF + wr * 64 + m * 16 + fr]; }
#pragma unroll
        for (int bj = 0; bj < 2; ++bj) {
            const int col = lyr * 256 + wc * 64 + 32 * bj + 8 * fq;
            f32x4 k0 = {1.f, 1.f, 1.f, 1.f}, k1 = k0, q0 = k0, q1 = k0;
            if (isk) { k0 = *(const f32x4*)(kg + col); k1 = *(const f32x4*)(kg + col + 4); q0 = *(const f32x4*)(qg + col); q1 = *(const f32x4*)(qg + col + 4); }
#pragma unroll
            for (int e = 0; e < 4; ++e) { gk[bj][e] = k0[e] * q0[e]; gk[bj][4 + e] = k1[e] * q1[e]; }
        }
        if (isk) {
#pragma unroll
            for (int ai = 0; ai < 2; ++ai)
#pragma unroll
                for (int m = 0; m < 4; ++m) {
                    const int rt = ai * HALF + wr * 64 + m * 16 + fr; const float rs = rsv[ai][m]; float ss = 0.f;
#pragma unroll
                    for (int bj = 0; bj < 2; ++bj)
#pragma unroll
                        for (int n = 0; n < 2; ++n)
#pragma unroll
                            for (int e = 0; e < 4; ++e) { const float v = acc[ai][bj][m][n][e] * rs; ss += v * v; }
                    ss += __shfl_xor(ss, 16); ss += __shfl_xor(ss, 32);
                    if (fq == 0) P[rt * 4 + wc] = ss;
                }
            asm volatile("s_waitcnt lgkmcnt(0)" ::: "memory"); __builtin_amdgcn_s_barrier(); asm volatile("" ::: "memory");
        }
        bf16_t* dst = isk ? KXN : VX;
#pragma unroll
        for (int ai = 0; ai < 2; ++ai)
#pragma unroll
            for (int m = 0; m < 4; ++m) {
                const int rt = ai * HALF + wr * 64 + m * 16 + fr;
                float sc = rsv[ai][m];
                if (isk) { const f32x4 p4 = *(const PG8_LAS f32x4*)(P + rt * 4); sc *= __builtin_amdgcn_rsqf(((p4[0] + p4[1]) + (p4[2] + p4[3])) * (1.0f / 256.0f) + 1e-6f); }
#pragma unroll
                for (int bj = 0; bj < 2; ++bj) {
                    const int col = wc * 64 + 32 * bj + 8 * fq;
                    float v[8];
#pragma unroll
                    for (int n = 0; n < 2; ++n)
#pragma unroll
                        for (int e = 0; e < 4; ++e) v[4 * n + e] = acc[ai][bj][m][n][e] * sc * gk[bj][4 * n + e];
                    const int ch = col >> 3;
                    const unsigned off = (unsigned)((u.pm * 4 + head) * 65536 + rt * 256 + ((ch ^ (isk ? (rt & 15) : ((rt & 3) << 2))) << 3));
                    *(u32x4*)(dst + off) = pack8(v);
                }
                asm volatile("" ::: "memory");
            }
        if (isk) { asm volatile("s_waitcnt lgkmcnt(0)" ::: "memory"); __builtin_amdgcn_s_barrier(); asm volatile("" ::: "memory"); }
    }
};
struct EpiStoreQT {
    bf16_t* O; const float* SS;
    __device__ __forceinline__ void operator()(const f32x4 (&acc)[2][2][4][2], const Unit& u, int wr, int wc, int fr, int fq, PG8_LAS unsigned char* lds) const {
        float rsv[2][4]; rstd8(rsv, lds, SS, u.pm, wr, fr);
#pragma unroll
        for (int ai = 0; ai < 2; ++ai)
#pragma unroll
            for (int m = 0; m < 4; ++m) {
                const int rt = ai * HALF + wr * 64 + m * 16 + fr, row = u.pm * BM + rt; (void)row;
                const float rs = rsv[ai][m];
#pragma unroll
                for (int bj = 0; bj < 2; ++bj) {
                    const int sidx = 4 * wc + 2 * bj + (fq >> 1);
                    const unsigned off = (unsigned)(((((u.pm * 4 + u.pn) * 8 + (rt >> 5)) * 16 + sidx) * 32 + (rt & 31)) * 16 + 8 * (fq & 1));
                    float v[8];
#pragma unroll
                    for (int n = 0; n < 2; ++n)
#pragma unroll
                        for (int e = 0; e < 4; ++e) v[4 * n + e] = acc[ai][bj][m][n][e] * rs;
                    *(u32x4*)(O + off) = pack8(v);
                }
            }
    }
};
template <bool BASE32, bool OUT32> struct EpiResid {
    const float* base32; float* out32; bf16_t* XH; float* SS;
    __device__ __forceinline__ void operator()(const f32x4 (&acc)[2][2][4][2], const Unit& u, int wr, int wc, int fr, int fq, PG8_LAS unsigned char* lds) const {
        const int c0 = u.pn * BM + wc * 64 + 8 * fq;
#pragma unroll
        for (int ai = 0; ai < 2; ++ai)
#pragma unroll
            for (int m = 0; m < 4; ++m) {
                const int row = u.pm * BM + ai * HALF + wr * 64 + m * 16 + fr; float ss = 0.f;
#pragma unroll
                for (int bj = 0; bj < 2; ++bj) {
                    const unsigned off = (unsigned)row * 1024u + (unsigned)c0 + 32u * bj;
                    f32x4 o0, o1;
                    if (BASE32) { o0 = *(const f32x4*)(base32 + off); o1 = *(const f32x4*)(base32 + off + 4); }
                    else { const u32x4 bw = *(const u32x4*)(XH + off); const f32x2 a = unpk_f16(bw.x), b = unpk_f16(bw.y), c = unpk_f16(bw.z), d = unpk_f16(bw.w);
                           o0 = (f32x4){a.x, a.y, b.x, b.y}; o1 = (f32x4){c.x, c.y, d.x, d.y}; }
                    o0 += acc[ai][bj][m][0]; o1 += acc[ai][bj][m][1];
                    if (OUT32) { *(f32x4*)(out32 + off) = o0; *(f32x4*)(out32 + off + 4) = o1; }
                    else {
                    u32x4 w; w.x = cvt_pk_f16(o0[0], o0[1]); w.y = cvt_pk_f16(o0[2], o0[3]); w.z = cvt_pk_f16(o1[0], o1[1]); w.w = cvt_pk_f16(o1[2], o1[3]);
                    *(u32x4*)(XH + off) = w;
                    ss += (o0[0] * o0[0] + o0[1] * o0[1]) + (o0[2] * o0[2] + o0[3] * o0[3]) + (o1[0] * o1[0] + o1[1] * o1[1]) + (o1[2] * o1[2] + o1[3] * o1[3]);
                    }
                }
                if (!OUT32) {
                ss += __shfl_xor(ss, 16); ss += __shfl_xor(ss, 32);
                if (fq == 0) SS[(unsigned)row * 16u + (unsigned)(u.pn * 4 + wc)] = ss;
                }
            }
    }
};
struct EpiSwiglu {
    bf16_t* HID; int ldc; const float* SS;
    __device__ __forceinline__ void operator()(const f32x4 (&acc)[2][2][4][2], const Unit& u, int wr, int wc, int fr, int fq, PG8_LAS unsigned char* lds) const {
        const int col = u.pn * 128 + wc * 32 + 8 * fq;
        float rsv[2][4]; rstd8(rsv, lds, SS, u.pm, wr, fr);
#pragma unroll
        for (int ai = 0; ai < 2; ++ai)
#pragma unroll
            for (int m = 0; m < 4; ++m) {
                const int row = u.pm * BM + ai * HALF + wr * 64 + m * 16 + fr; const float rs = rsv[ai][m];
                float v[8];
#pragma unroll
                for (int n = 0; n < 2; ++n)
#pragma unroll
                    for (int e = 0; e < 4; ++e) { const float g = acc[ai][0][m][n][e] * rs, uu = acc[ai][1][m][n][e] * rs; v[4 * n + e] = g * __builtin_amdgcn_rcpf(1.0f + __expf(-g)) * uu; }
                *(u32x4*)(HID + ((unsigned)row * (unsigned)ldc + (unsigned)col)) = pack8(v);
            }
    }
};
struct EpiEven {
    const float* SS; const float* rope;
    const float *q_gain, *k_gain, *ln_g, *ln_b;
    bf16_t *Q, *K, *V, *U, *VN; float* KMP;
    template <int TYPE> __device__ __forceinline__ void tile(const f32x4 (&acc)[2][2][4][2], const float (&rsv)[2][4], const Unit& u, int wr, int wc, int fr, int fq, PG8_LAS unsigned char* lds) const {
        asm volatile("; even tile type %0" :: "n"(TYPE) : "memory");
        const int head = (u.pn & 1) * 4 + wc, cb = head * 64 + 8 * fq;
        bf16_t* dst = TYPE == 0 ? Q : TYPE == 1 ? K : TYPE == 2 ? V : TYPE == 3 ? U : VN;
        const PG8_LAS float* gt = (const PG8_LAS float*)(lds + EV_GAIN_TAB);
        float gn[2][8], bb[2][8], ks[2][8];
#pragma unroll
        for (int bj = 0; bj < 2; ++bj)
#pragma unroll
            for (int e = 0; e < 8; ++e) {
                gn[bj][e] = 1.f; bb[bj][e] = 0.f; ks[bj][e] = 0.f;
                if (TYPE == 0) gn[bj][e] = gt[32 * bj + 8 * fq + e];
                if (TYPE == 1) gn[bj][e] = gt[64 + 32 * bj + 8 * fq + e];
                if (TYPE == 4) { gn[bj][e] = gt[128 + cb + 32 * bj + e]; bb[bj][e] = gt[640 + cb + 32 * bj + e]; }
            }
#pragma unroll
        for (int ai = 0; ai < 2; ++ai)
#pragma unroll
            for (int m = 0; m < 4; ++m) {
                const int row = u.pm * BM + ai * HALF + wr * 64 + m * 16 + fr; const float rs = rsv[ai][m];
                float v[2][8];
#pragma unroll
                for (int bj = 0; bj < 2; ++bj)
#pragma unroll
                    for (int n = 0; n < 2; ++n)
#pragma unroll
                        for (int e = 0; e < 4; ++e) v[bj][4 * n + e] = acc[ai][bj][m][n][e] * rs;
                if (TYPE == 0 || TYPE == 1) {
                    float ss = 0.f;
#pragma unroll
                    for (int bj = 0; bj < 2; ++bj)
#pragma unroll
                        for (int e = 0; e < 8; ++e) ss += v[bj][e] * v[bj][e];
                    ss += __shfl_xor(ss, 16); ss += __shfl_xor(ss, 32);
                    const float rn = __builtin_amdgcn_rsqf(ss * (1.0f / 64.0f) + 1e-6f);
#pragma unroll
                    for (int bj = 0; bj < 2; ++bj)
#pragma unroll
                        for (int e = 0; e < 8; ++e) v[bj][e] = v[bj][e] * rn * gn[bj][e];
                    float pr[8];
#pragma unroll
                    for (int e = 0; e < 8; ++e) pr[e] = __shfl_xor(v[0][e], 16);
                    if (fq < 2) {
                        const PG8_LAS unsigned char* rp = lds + EV_ROPE_TAB + (ai * HALF + wr * 64 + m * 16 + fr) * 32;
                        const u32x4 cw = *(const PG8_LAS u32x4*)rp, sw = *(const PG8_LAS u32x4*)(rp + 16);
                        const f32x2 ca = unpk_f16(cw.x), cb_ = unpk_f16(cw.y), cc = unpk_f16(cw.z), cd = unpk_f16(cw.w), sa = unpk_f16(sw.x), sb = unpk_f16(sw.y), sc = unpk_f16(sw.z), sd = unpk_f16(sw.w);
                        const f32x4 c0 = {ca.x, ca.y, cb_.x, cb_.y}, c1 = {cc.x, cc.y, cd.x, cd.y}, s0 = {sa.x, sa.y, sb.x, sb.y}, s1 = {sc.x, sc.y, sd.x, sd.y};
                        const float sg = fq == 0 ? -1.f : 1.f;
#pragma unroll
                        for (int e = 0; e < 4; ++e) { v[0][e] = v[0][e] * c0[e] + sg * pr[e] * s0[e]; v[0][4 + e] = v[0][4 + e] * c1[e] + sg * pr[4 + e] * s1[e]; }
                    }
                    if (TYPE == 1) {
#pragma unroll
                        for (int bj = 0; bj < 2; ++bj)
#pragma unroll
                            for (int e = 0; e < 8; ++e) { ks[bj][e] += v[bj][e]; asm volatile("" : "+v"(ks[bj][e])); }
                    }
                }
                if (TYPE == 3 || TYPE == 4) {
#pragma unroll
                    for (int bj = 0; bj < 2; ++bj)
#pragma unroll
                        for (int e = 0; e < 8; e += 2) { const f32x2 g = gelu_pk((f32x2){v[bj][e], v[bj][e + 1]}); v[bj][e] = g.x; v[bj][e + 1] = g.y; }
                }
                if (TYPE == 4) {
                    float s = 0.f;
#pragma unroll
                    for (int bj = 0; bj < 2; ++bj)
#pragma unroll
                        for (int e = 0; e < 8; ++e) s += v[bj][e];
                    s += __shfl_xor(s, 16); s += __shfl_xor(s, 32);
                    const float mu = s * (1.0f / 64.0f); float q = 0.f;
#pragma unroll
                    for (int bj = 0; bj < 2; ++bj)
#pragma unroll
                        for (int e = 0; e < 8; ++e) { v[bj][e] -= mu; q += v[bj][e] * v[bj][e]; }
                    q += __shfl_xor(q, 16); q += __shfl_xor(q, 32);
                    const float rn = __builtin_amdgcn_rsqf(q * (1.0f / 64.0f) + 1e-6f);
#pragma unroll
                    for (int bj = 0; bj < 2; ++bj)
#pragma unroll
                        for (int e = 0; e < 8; ++e) v[bj][e] = v[bj][e] * rn * gn[bj][e] + bb[bj][e];
                }
#pragma unroll
                for (int bj = 0; bj < 2; ++bj) *(u32x4*)(dst + ((unsigned)row * 512u + (unsigned)cb + 32u * bj)) = pack8(v[bj]);
                asm volatile("" ::: "memory");
            }
        if (TYPE == 1) {
#pragma unroll
            for (int bj = 0; bj < 2; ++bj)
#pragma unroll
                for (int e = 0; e < 8; ++e) { float s = ks[bj][e]; s += __shfl_xor(s, 1); s += __shfl_xor(s, 2); s += __shfl_xor(s, 4); s += __shfl_xor(s, 8); ks[bj][e] = s; }
            if (fr == 0) {
                float* kp = KMP + (unsigned)((u.pm * 2 + wr) * 512 + cb);
#pragma unroll
                for (int bj = 0; bj < 2; ++bj)
#pragma unroll
                    for (int e = 0; e < 8; ++e) kp[32 * bj + e] = ks[bj][e];
            }
        }
        asm volatile("; end even tile type %0" :: "n"(TYPE) : "memory");
    }
    __device__ __forceinline__ void tables(PG8_LAS unsigned char* lds, int tid, int pm) const {
        const float *ss_ = SS, *rope_ = rope, *qg_ = q_gain, *kg_ = k_gain, *lg_ = ln_g, *lb_ = ln_b; int pmv = pm;
        asm volatile("" : "+s"(ss_), "+s"(rope_), "+s"(qg_), "+s"(kg_), "+s"(lg_), "+s"(lb_), "+s"(pmv));
        if (tid < 256) ((PG8_LAS float*)(lds + RSTD_TAB))[tid] = row_rstd(ss_, pmv * BM + tid);
        { const int row = tid >> 1, part = tid & 1; const float* rp = rope_ + (unsigned)(pmv * BM + row) * 16u + 8 * part;
          const f32x4 a = *(const f32x4*)rp, b = *(const f32x4*)(rp + 4);
          u32x4 w; w.x = cvt_pk_f16(a[0], a[1]); w.y = cvt_pk_f16(a[2], a[3]); w.z = cvt_pk_f16(b[0], b[1]); w.w = cvt_pk_f16(b[2], b[3]);
          *(PG8_LAS u32x4*)(lds + EV_ROPE_TAB + row * 32 + part * 16) = w; }
        { PG8_LAS float* gt = (PG8_LAS float*)(lds + EV_GAIN_TAB);
          if (tid < 64) gt[tid] = qg_[tid]; else if (tid < 128) gt[tid] = kg_[tid - 64];
          gt[128 + tid] = lg_[tid]; gt[640 + tid] = lb_[tid]; }
        if (tid == 0) *(PG8_LAS int*)(lds + RSTD_TAB + 1024) = pmv;
    }
    __device__ __forceinline__ void prefill(PG8_LAS unsigned char* lds, int tid, int pm) const { tables(lds, tid, pm); asm volatile("s_waitcnt lgkmcnt(0)" ::: "memory"); }
    __device__ __forceinline__ void operator()(const f32x4 (&acc)[2][2][4][2], const Unit& u, int wr, int wc, int fr, int fq, PG8_LAS unsigned char* lds) const {
        asm volatile("" : "+v"(fr), "+v"(fq));
        const int type = pn_logical(0xFEDCBA5476983210ull, u.pn) >> 1;
        if (*(const PG8_LAS int*)(lds + RSTD_TAB + 1024) != u.pm) {
            __syncthreads();
            tables(lds, (wr * 4 + wc) * 64 + fq * 16 + fr, u.pm);
            __syncthreads();
        }
        float rsv[2][4];
        { const PG8_LAS float* tab = (const PG8_LAS float*)(lds + RSTD_TAB);
#pragma unroll
          for (int ai = 0; ai < 2; ++ai)
#pragma unroll
            for (int m = 0; m < 4; ++m) rsv[ai][m] = tab[ai * HALF + wr * 64 + m * 16 + fr]; }
        if (type == 0) tile<0>(acc, rsv, u, wr, wc, fr, fq, lds);
        else if (type == 1) tile<1>(acc, rsv, u, wr, wc, fr, fq, lds);
        else if (type == 2) tile<2>(acc, rsv, u, wr, wc, fr, fq, lds);
        else if (type == 3) tile<3>(acc, rsv, u, wr, wc, fr, fq, lds);
        else tile<4>(acc, rsv, u, wr, wc, fr, fq, lds);
    }
};

template <class Epi, class Sched, bool ALIGN_EPI, bool F16 = false, bool PREFILL = false>
__device__ __forceinline__ void gemm_phase(PG8_LAS unsigned char* lds, const Gemm g, const Sched& S, const Epi& E, int wid, const float* rstd_SS = nullptr) {
    asm volatile("" : "+s"(wid));
    int lane; asm volatile("v_mbcnt_lo_u32_b32 %0, -1, 0\n\tv_mbcnt_hi_u32_b32 %0, -1, %0" : "=v"(lane));
    const int tid = wid * 64 + lane, wr = wid >> 2, wc = wid & 3, fr = lane & 15, fq = lane >> 4;
    const int K = g.K, nt = K / BK;
    unsigned voffA[2], voffB[2];
#pragma unroll
    for (int i = 0; i < 2; ++i) { int R, C; stage_rc(tid * 16 + i * 8192, R, C); const int Rb = g.bGrp * (R >> 5) + perm32(R & 31);
        voffA[i] = (unsigned)(R * K + C) * 2u; voffB[i] = (unsigned)(Rb * K + C) * 2u; }
    const size_t kstep = (size_t)(BK * 2);
    const size_t hstepA = (size_t)HALF * K * 2, tstepA = 2 * hstepA;
    const size_t hstepB = (size_t)g.bHalf * K * 2, tstepB = (size_t)g.bTile * K * 2;
    const unsigned ldsw = (unsigned)wid * 1024u;
    const int aoff = lds_byte(wr * 64 + fr, fq * 8), boff = lds_byte(wc * 32 + fr, fq * 8);
#define PG8_SA(b, h) (((b) * 2 + (h)) * HTB)
#define PG8_SB(b, h) ((4 + (b) * 2 + (h)) * HTB)
#define PG8_STAGE(bufoff, gbase, voff) do { _Pragma("unroll") for (int _i = 0; _i < 2; ++_i) \
        __builtin_amdgcn_global_load_lds((const unsigned*)((const char*)(gbase) + (voff)[_i]), (PG8_LAS unsigned*)(lds + (bufoff) + ldsw + _i * 8192), 16, 0, 0); } while (0)
#define PG8_LDA(dst, b, h) do { _Pragma("unroll") for (int m = 0; m < 4; ++m) _Pragma("unroll") for (int k = 0; k < 2; ++k) dst[m][k] = *(const PG8_LAS bf16x8*)(lds + PG8_SA(b, h) + aoff + m * 2048 + k * 1024); } while (0)
#define PG8_LDB(dst, b, h) do { _Pragma("unroll") for (int n = 0; n < 2; ++n) _Pragma("unroll") for (int k = 0; k < 2; ++k) dst[n][k] = *(const PG8_LAS bf16x8*)(lds + PG8_SB(b, h) + boff + n * 2048 + k * 1024); } while (0)
#define PG8_MMA(ai, bj, At, Bt) do { __builtin_amdgcn_s_setprio(1); _Pragma("unroll") for (int m = 0; m < 4; ++m) _Pragma("unroll") for (int n = 0; n < 2; ++n) _Pragma("unroll") for (int k = 0; k < 2; ++k) \
        acc[ai][bj][m][n] = F16 ? __builtin_amdgcn_mfma_f32_16x16x32_f16(__builtin_bit_cast(half8_t, Bt[n][k]), __builtin_bit_cast(half8_t, At[m][k]), acc[ai][bj][m][n], 0, 0, 0) \
                                : __builtin_amdgcn_mfma_f32_16x16x32_bf16(Bt[n][k], At[m][k], acc[ai][bj][m][n], 0, 0, 0); __builtin_amdgcn_s_setprio(0); } while (0)
#define PG8_WAIT_V(n) asm volatile("s_waitcnt vmcnt(" #n ")" ::: "memory")
#define PG8_WAIT_L(n) asm volatile("s_waitcnt lgkmcnt(" #n ")" ::: "memory")
#define PG8_BAR __builtin_amdgcn_s_barrier()
#define PG8_SCHED __builtin_amdgcn_sched_barrier(0)
#define PG8_PA(u) ((const char*)g.A + (size_t)((u).pm % g.aTileMod) * tstepA)
#define PG8_PB(u) ((const char*)g.Bt + (size_t)pn_logical(g.pnmap, (u).pn) * tstepB + (size_t)((u).pm / g.aTileMod) * g.bBatchBytes)
    Unit cur, nxt; int ui = 0;
    if (!S.next(0, cur)) return;
    f32x4 acc[2][2][4][2];
#pragma unroll
    for (int a = 0; a < 2; ++a)
#pragma unroll
        for (int b = 0; b < 2; ++b)
#pragma unroll
            for (int m = 0; m < 4; ++m)
#pragma unroll
                for (int n = 0; n < 2; ++n) acc[a][b][m][n] = (f32x4){0.f, 0.f, 0.f, 0.f};
    bf16x8 At[4][2], B0[2][2], B1[2][2];
    const char* cA = PG8_PA(cur); const char* cB = PG8_PB(cur);
    PG8_STAGE(PG8_SB(0, 0), cB, voffB); PG8_STAGE(PG8_SB(0, 1), cB + hstepB, voffB); PG8_STAGE(PG8_SA(0, 0), cA, voffA); PG8_STAGE(PG8_SA(0, 1), cA + hstepA, voffA);
    if constexpr (PREFILL) E.prefill(lds, tid, cur.pm);
    if (rstd_SS) {
        const float* ssp = rstd_SS; asm volatile("" : "+s"(ssp));
        if (tid < 256) ((PG8_LAS float*)(lds + RSTD_TAB))[tid] = row_rstd(ssp, cur.pm * BM + tid);
        int pmv = cur.pm; asm volatile("" : "+s"(pmv));
        if (tid == 0) *(PG8_LAS int*)(lds + RSTD_TAB + 1024) = pmv;
        PG8_WAIT_L(0);
    }
    if (wr == 1) PG8_BAR;
    PG8_WAIT_V(2); PG8_BAR;
    PG8_STAGE(PG8_SB(1, 0), cB + kstep, voffB); PG8_STAGE(PG8_SA(1, 0), cA + kstep, voffA); PG8_STAGE(PG8_SB(1, 1), cB + hstepB + kstep, voffB);
    PG8_WAIT_V(6); PG8_BAR;
    for (;;) {
        const bool has_next = S.next(ui + 1, nxt);
        const char* nA = has_next ? PG8_PA(nxt) : cA; const char* nB = has_next ? PG8_PB(nxt) : cB;
        for (int t = 0; t < nt; t += 2) {
            const bool last = (t == nt - 2);
            const char* a1 = cA + (size_t)(t + 1) * kstep;
            const char* a2 = last ? nA : cA + (size_t)(t + 2) * kstep; const char* b2 = last ? nB : cB + (size_t)(t + 2) * kstep;
            const char* a3 = a2 + kstep; const char* b3 = b2 + kstep;
            PG8_LDB(B0, 0, 0); PG8_LDB(B1, 0, 1); PG8_SCHED; PG8_LDA(At, 0, 0); PG8_STAGE(PG8_SA(1, 1), a1 + hstepA, voffA);
            PG8_WAIT_V(8); PG8_WAIT_L(0); PG8_BAR; PG8_MMA(0, 0, At, B0); PG8_MMA(0, 1, At, B1); PG8_BAR; PG8_SCHED;
            const bool drain = last && !has_next;
            PG8_LDA(At, 0, 1);
            if (!drain) { PG8_STAGE(PG8_SB(0, 0), b2, voffB); PG8_STAGE(PG8_SB(0, 1), b2 + hstepB, voffB); PG8_STAGE(PG8_SA(0, 0), a2, voffA); PG8_WAIT_V(8); } else { PG8_WAIT_V(2); }
            PG8_WAIT_L(0); PG8_BAR; PG8_MMA(1, 0, At, B0); PG8_MMA(1, 1, At, B1); PG8_BAR; PG8_SCHED;
            PG8_LDB(B0, 1, 0); PG8_LDB(B1, 1, 1); PG8_SCHED; PG8_LDA(At, 1, 0);
            if (!drain) { PG8_STAGE(PG8_SA(0, 1), a2 + hstepA, voffA); PG8_WAIT_V(8); } else { PG8_WAIT_V(0); }
            PG8_WAIT_L(0); PG8_BAR; PG8_MMA(0, 0, At, B0); PG8_MMA(0, 1, At, B1); PG8_BAR; PG8_SCHED;
            PG8_LDA(At, 1, 1);
            if (!drain) { PG8_STAGE(PG8_SB(1, 0), b3, voffB); PG8_STAGE(PG8_SB(1, 1), b3 + hstepB, voffB); PG8_STAGE(PG8_SA(1, 0), a3, voffA); PG8_WAIT_V(8); }
            PG8_WAIT_L(0); PG8_BAR; PG8_MMA(1, 0, At, B0); PG8_MMA(1, 1, At, B1); PG8_BAR; PG8_SCHED;
        }
        if constexpr (ALIGN_EPI) { if (wr == 0) PG8_BAR; }
        E(acc, cur, wr, wc, fr, fq, lds);
        if (!has_next) break;
#pragma unroll
        for (int a = 0; a < 2; ++a)
#pragma unroll
            for (int b = 0; b < 2; ++b)
#pragma unroll
                for (int m = 0; m < 4; ++m)
#pragma unroll
                    for (int n = 0; n < 2; ++n) acc[a][b][m][n] = (f32x4){0.f, 0.f, 0.f, 0.f};
        cur = nxt; cA = nA; cB = nB; ++ui;
        if constexpr (ALIGN_EPI) { if (wr == 1) PG8_BAR; }
    }
    PG8_WAIT_V(0);
    if constexpr (!ALIGN_EPI) { if (wr == 0) PG8_BAR; }
    PG8_BAR;
#undef PG8_SA
#undef PG8_SB
#undef PG8_STAGE
#undef PG8_LDA
#undef PG8_LDB
#undef PG8_MMA
#undef PG8_WAIT_V
#undef PG8_WAIT_L
#undef PG8_BAR
#undef PG8_SCHED
#undef PG8_PA
#undef PG8_PB
}
}

constexpr int NWAVES = 8;
constexpr int BATCH = 8, SEQ = 2048, D = 1024, DEPTH = 4, M = BATCH * SEQ, NMEM = 256, MM = BATCH * NMEM;
constexpr int EV_IN = 2560, OD_IN = 3072, DFF = 2816;
constexpr float EPSF = 1e-6f;

constexpr size_t MiB = (size_t)1 << 20;
constexpr size_t WS_ROPE = 1 * MiB, WS_SS = 2 * MiB, WS_T16 = 3 * MiB, WS_KMP = 4 * MiB, WS_SSM = 5 * MiB, WS_WSB = 6 * MiB, WS_W1G = 7 * MiB;
constexpr size_t WS_W = 8 * MiB;
constexpr size_t WS_XB = 136 * MiB, WS_CAT = 168 * MiB, WS_KXN = 200 * MiB, WS_VX = 216 * MiB, WS_RA = 232 * MiB, WS_END = 352 * MiB;
constexpr size_t Mi = (size_t)1 << 20;
constexpr size_t W_EVIN = 0, W_EVOUT = 5 * Mi, W_ODIN = 7 * Mi, W_ODOUT = 13 * Mi, W_XQ = 15 * Mi, W_XKV = 19 * Mi, W_XO = 27 * Mi, W_GU = 31 * Mi, W_DN = 53 * Mi;
constexpr size_t SZ_EVIN = (size_t)EV_IN * D, SZ_ODIN = (size_t)OD_IN * D, SZ_GU = (size_t)2 * DFF * D, SZ_DN = (size_t)DFF * D;

constexpr int RING_BYTES = 131072, MISC_OFF = 147456, LDS_BYTES = 147456 + 256;

#define LAS __attribute__((address_space(3)))
typedef unsigned short bf16;
typedef unsigned v4u __attribute__((ext_vector_type(4)));
typedef unsigned v2u __attribute__((ext_vector_type(2)));
typedef float f32x4 __attribute__((ext_vector_type(4)));
#define LDS_WAIT() asm volatile("s_waitcnt lgkmcnt(0)" ::: "memory")
__device__ __forceinline__ unsigned f2bf(float f) { unsigned u = __builtin_bit_cast(unsigned, f); return (u + 0x7fffu + ((u >> 16) & 1u)) >> 16; }
__device__ __forceinline__ unsigned pk2(float lo, float hi) { return f2bf(lo) | (f2bf(hi) << 16); }
__device__ __forceinline__ float bflo(unsigned w) { return __uint_as_float(w << 16); }
__device__ __forceinline__ float bfhi(unsigned w) { return __uint_as_float(w & 0xffff0000u); }
__device__ __forceinline__ float bf1(bf16 h) { return __uint_as_float((unsigned)h << 16); }
__device__ __forceinline__ float wave_sum(float v) {
#pragma unroll
    for (int o = 1; o < 64; o <<= 1) v += __shfl_xor(v, o);
    return v;
}
__device__ __forceinline__ float wave_max(float v) {
#pragma unroll
    for (int o = 1; o < 64; o <<= 1) v = fmaxf(v, __shfl_xor(v, o));
    return v;
}

__device__ __forceinline__ int hw_lane() { int l; asm volatile("v_mbcnt_lo_u32_b32 %0, -1, 0\n\tv_mbcnt_hi_u32_b32 %0, -1, %0" : "=v"(l)); return l; }
struct Args { const void* in[28]; float* out; unsigned char* ws; int pad0, pad1; };

typedef const unsigned char __attribute__((address_space(4)))* kargp_t;
struct Frame {
    LAS unsigned char* lds;
    int tid, lane, wave, vcu, G;
    kargp_t kp;
    __device__ __forceinline__ const float* inf(int k) const { return *(const float* const __attribute__((address_space(4)))*)(kp + 8 * k); }
    __device__ __forceinline__ const int* ini(int k) const { return *(const int* const __attribute__((address_space(4)))*)(kp + 8 * k); }
    __device__ __forceinline__ float* outp() const { return *(float* const __attribute__((address_space(4)))*)(kp + 224); }
    __device__ __forceinline__ unsigned char* wsb() const { return *(unsigned char* const __attribute__((address_space(4)))*)(kp + 232); }
    __device__ __forceinline__ float* wsf(size_t off) const { return (float*)(wsb() + off); }
    __device__ __forceinline__ bf16* wsh(size_t off) const { return (bf16*)(wsb() + off); }
    __device__ __forceinline__ void fresh() { lane = hw_lane(); asm volatile("" : "+s"(kp), "+v"(lane)); tid = wave * 64 + lane; }
};
enum { I_X = 0, I_MEM, I_POS, I_NORM_MIX, I_NORM_MEM_Q, I_NORM_MEM_KV, I_NORM_FFN, I_EV_W_IN, I_EV_Q_GAIN, I_EV_K_GAIN, I_EV_W_S, I_EV_B_S, I_EV_LN_G, I_EV_LN_B, I_EV_W_OUT,
       I_OD_W_IN, I_OD_W_G1, I_OD_W_G2, I_OD_B_G, I_OD_O_GAIN, I_OD_W_OUT, I_XA_W_Q, I_XA_W_KV, I_XA_Q_GAIN, I_XA_K_GAIN, I_XA_W_OUT, I_FFN_W_GU, I_FFN_W_DOWN };
#define F_X F.inf(I_X)
#define F_OUT F.outp()
#define F_MEMB ((bf16*)((unsigned char*)F.outp() + 32 * MiB))
#define F_W F.wsh(WS_W)
#define F_XB F.wsh(WS_XB)
#define F_CAT F.wsh(WS_CAT)
#define F_KXN F.wsh(WS_KXN)
#define F_VX F.wsh(WS_VX)
#define F_RA F.wsh(WS_RA)
#define F_ROPE F.wsf(WS_ROPE)
#define F_SS F.wsf(WS_SS)
#define F_T16 F.wsf(WS_T16)
#define F_KMP F.wsf(WS_KMP)
#define F_SSM F.wsf(WS_SSM)

struct P0Item { const float* W; const float* gain; bf16* WT; int K, N, item; bool f16; };
__device__ __forceinline__ void p0_load(const P0Item& d, int lane, float (&wv)[32], pg8::f32x4 (&gv)[2]) {
    const int nblk = d.N / 32, kb = d.item / nblk, nb = d.item % nblk, k0 = 64 * kb, n0 = 32 * nb;
    const float* wp = d.W + (size_t)(k0 + (lane >> 5)) * d.N + n0 + (lane & 31);
#pragma unroll
    for (int i = 0; i < 32; ++i) wv[i] = __builtin_nontemporal_load(wp + (size_t)(2 * i) * d.N);
    gv[0] = (pg8::f32x4){1.f, 1.f, 1.f, 1.f}; gv[1] = gv[0];
    if (d.gain) { const float* gp = d.gain + k0 + 8 * (lane & 7); gv[0] = *(const pg8::f32x4*)gp; gv[1] = *(const pg8::f32x4*)(gp + 4); }
}
__device__ __forceinline__ void p0_store(const P0Item& d, int lane, const float (&wv)[32], const pg8::f32x4 (&gv)[2], LAS float* scr) {
    const int nblk = d.N / 32, kb = d.item / nblk, nb = d.item % nblk, k0 = 64 * kb, n0 = 32 * nb;
#pragma unroll
    for (int i = 0; i < 32; ++i) scr[(2 * i + (lane >> 5)) * 33 + (lane & 31)] = wv[i];
    LDS_WAIT(); asm volatile("" ::: "memory");
    const int c = lane & 7;
#pragma unroll
    for (int j = 0; j < 4; ++j) { const int n = (lane >> 3) + 8 * j; const LAS float* sp = scr + (8 * c) * 33 + n;
        float e[8];
#pragma unroll
        for (int q = 0; q < 8; ++q) e[q] = sp[q * 33] * gv[q >> 2][q & 3];
        v4u o;
        if (d.f16) { o.x = pg8::cvt_pk_f16(e[0], e[1]); o.y = pg8::cvt_pk_f16(e[2], e[3]); o.z = pg8::cvt_pk_f16(e[4], e[5]); o.w = pg8::cvt_pk_f16(e[6], e[7]); }
        else { o.x = pg8::cvt_pk_bf16(e[0], e[1]); o.y = pg8::cvt_pk_bf16(e[2], e[3]); o.z = pg8::cvt_pk_bf16(e[4], e[5]); o.w = pg8::cvt_pk_bf16(e[6], e[7]); }
        *(v4u*)(d.WT + (size_t)(n0 + n) * d.K + k0 + 8 * c) = o; }
    LDS_WAIT(); asm volatile("" ::: "memory");
}
constexpr int P0_ITEMS_PRO = 4096 + 7040, P0_ITEMS_ALL = 32768;
__device__ __forceinline__ int p0_layer_first(int l) { return 4096 + (l >> 1) * 14336 + (l & 1) * 7040; }
__device__ __forceinline__ P0Item p0_decode(Frame& F, int r) {
    if (r < 4096) { const int l = r / 1024; return P0Item{F.inf(I_XA_W_KV) + (size_t)l * 2 * Mi, F.inf(I_NORM_MEM_KV) + l * D, F_W + W_XKV + l * 2 * Mi, D, 2 * D, r % 1024, false}; } r -= 4096;
    int l = 0; if (r >= 7040) { r -= 7040; l = 1; if (r >= 7296) { r -= 7296; l = 2; if (r >= 7040) { r -= 7040; l = 3; } } }
    const int li = l >> 1; const bool odd = (l & 1) != 0; const int nin = odd ? 1536 : 1280;
    if (r < nin) return odd ? P0Item{F.inf(I_OD_W_IN) + (size_t)li * SZ_ODIN, F.inf(I_NORM_MIX) + (2 * li + 1) * D, F_W + W_ODIN + li * SZ_ODIN, D, OD_IN, r, true}
                            : P0Item{F.inf(I_EV_W_IN) + (size_t)li * SZ_EVIN, F.inf(I_NORM_MIX) + (2 * li) * D, F_W + W_EVIN + li * SZ_EVIN, D, EV_IN, r, true};
    r -= nin;
    if (r < 512) return odd ? P0Item{F.inf(I_OD_W_OUT) + (size_t)li * Mi, nullptr, F_W + W_ODOUT + li * Mi, D, D, r, false} : P0Item{F.inf(I_EV_W_OUT) + (size_t)li * Mi, nullptr, F_W + W_EVOUT + li * Mi, D, D, r, false};
    r -= 512;
    if (r < 512) return P0Item{F.inf(I_XA_W_Q) + (size_t)l * Mi, F.inf(I_NORM_MEM_Q) + l * D, F_W + W_XQ + l * Mi, D, D, r, true};
    r -= 512;
    if (r < 512) return P0Item{F.inf(I_XA_W_OUT) + (size_t)l * Mi, nullptr, F_W + W_XO + l * Mi, D, D, r, false};
    r -= 512;
    if (r < 2816) return P0Item{F.inf(I_FFN_W_GU) + (size_t)l * SZ_GU, F.inf(I_NORM_FFN) + l * D, F_W + W_GU + l * SZ_GU, D, 2 * DFF, r, true};
    r -= 2816;
    return P0Item{F.inf(I_FFN_W_DOWN) + (size_t)l * SZ_DN, nullptr, F_W + W_DN + l * SZ_DN, DFF, D, r, false};
}
__device__ __forceinline__ void p0_convert(Frame& F, int first, int step, int end) {
    LAS float* scr = (LAS float*)(F.lds + F.wave * 16384);
    float wa[32], wb[32]; pg8::f32x4 ga[2], gb[2]; P0Item da, db;
    int it = first;
    if (it < end) { da = p0_decode(F, it); p0_load(da, F.lane, wa, ga); }
    for (; it < end; it += 2 * step) {
        const bool hb = it + step < end, ha = it + 2 * step < end;
        if (hb) { db = p0_decode(F, it + step); p0_load(db, F.lane, wb, gb); }
        p0_store(da, F.lane, wa, ga, scr);
        if (ha) { da = p0_decode(F, it + 2 * step); p0_load(da, F.lane, wa, ga); }
        if (hb) p0_store(db, F.lane, wb, gb, scr);
    }
}
__device__ __forceinline__ void row_to_bf16_ss(int lane, const float* xrow, bf16* orow, float* ssrow) {
    const f32x4* xr = (const f32x4*)xrow + lane; f32x4 v[4]; float s = 0.f;
#pragma unroll
    for (int j = 0; j < 4; ++j) { v[j] = xr[64 * j]; s += (v[j][0] * v[j][0] + v[j][1] * v[j][1]) + (v[j][2] * v[j][2] + v[j][3] * v[j][3]); }
    s = wave_sum(s);
    v2u* o8 = (v2u*)orow + lane;
#pragma unroll
    for (int j = 0; j < 4; ++j) { v2u w; w.x = pk2(v[j][0], v[j][1]); w.y = pk2(v[j][2], v[j][3]); o8[64 * j] = w; }
    if (lane < 16) ssrow[lane] = lane == 0 ? s : 0.f;
}
__device__ __forceinline__ void p0_prologue(Frame& F) {
    LAS float* scr = (LAS float*)(F.lds + F.wave * 16384);
    const int gw = F.vcu * NWAVES + F.wave, NGW = F.G * NWAVES;
    p0_convert(F, gw, NGW, F.G == 256 ? P0_ITEMS_PRO : P0_ITEMS_ALL);
    for (int m4 = gw * 4; m4 < M; m4 += NGW * 4) {
        const float* xs = F_X; bf16* xb = F_XB; float* ssp = F_SS;
        f32x4 v[4][4]; float sq[4];
#pragma unroll
        for (int r = 0; r < 4; ++r)
#pragma unroll
            for (int j = 0; j < 4; ++j) v[r][j] = ((const f32x4*)(xs + (size_t)(m4 + r) * D))[F.lane + 64 * j];
#pragma unroll
        for (int r = 0; r < 4; ++r) { float q = 0.f;
#pragma unroll
            for (int j = 0; j < 4; ++j) q += (v[r][j][0] * v[r][j][0] + v[r][j][1] * v[r][j][1]) + (v[r][j][2] * v[r][j][2] + v[r][j][3] * v[r][j][3]);
            sq[r] = wave_sum(q); }
#pragma unroll
        for (int r = 0; r < 4; ++r) { v2u* o8 = (v2u*)(xb + (size_t)(m4 + r) * D) + F.lane;
#pragma unroll
            for (int j = 0; j < 4; ++j) { v2u w; w.x = pg8::cvt_pk_f16(v[r][j][0], v[r][j][1]); w.y = pg8::cvt_pk_f16(v[r][j][2], v[r][j][3]); o8[64 * j] = w; }
            if (F.lane < 16) ssp[(size_t)(m4 + r) * 16 + F.lane] = F.lane == 0 ? sq[r] : 0.f; }
    }
    for (int m = gw; m < MM; m += NGW) row_to_bf16_ss(F.lane, F.inf(I_MEM) + (size_t)m * D, F_MEMB + (size_t)m * D, F_SSM + (size_t)m * 16);
    for (int idx = (F.vcu * NWAVES * 64) + F.tid; idx < M * 8; idx += F.G * NWAVES * 64) {
        const int token = idx >> 3, i = idx & 7;
        const float invf = __builtin_amdgcn_exp2f(-(float)i * 0.125f * 18.931568569324174f);
        const float ang = (float)F.ini(I_POS)[token] * invf;
        double t = (double)ang * 0.15915494309189535; t -= __builtin_floor(t);
        F_ROPE[(size_t)token * 16 + i] = __builtin_amdgcn_cosf((float)t);
        F_ROPE[(size_t)token * 16 + 8 + i] = __builtin_amdgcn_sinf((float)t);
    }
    { const float* w1 = F.inf(I_OD_W_G1); const float* nm = F.inf(I_NORM_MIX); _Float16* wd = (_Float16*)F.wsh(WS_W1G);
      for (int idx = (F.vcu * NWAVES * 64) + F.tid; idx < 2 * 16 * 1024; idx += F.G * NWAVES * 64) { const int li_ = idx >> 14, r = (idx >> 10) & 15, k = idx & 1023;
          wd[idx] = (_Float16)(w1[(size_t)li_ * D * 16 + k * 16 + r] * nm[(2 * li_ + 1) * D + k]); } }
    { const float* wsrc = F.inf(I_EV_W_S); bf16* wdst = F.wsh(WS_WSB);
      for (int idx = (F.vcu * NWAVES * 64) + F.tid; idx < 2 * 8 * 128 * 128; idx += F.G * NWAVES * 64) { const int i = (idx >> 7) & 127, j = idx & 127; wdst[idx] = (bf16)f2bf(j <= i ? wsrc[idx] : 0.f); } }
}

__device__ __forceinline__ void gate_t16(Frame& F, int l, int li) {
    (void)l;
    const _Float16* W1G = (const _Float16*)F.wsh(WS_W1G) + (size_t)li * 16 * 1024; const _Float16* XH = (const _Float16*)F_XB; float* T16 = F_T16; const float* SS = F_SS;
    const int lane = F.lane, c16 = lane & 15, kq = lane >> 4;
    const bool b256 = (F.G == 256);
    int tile = b256 ? ((F.vcu >> 5) * 128 + (F.vcu & 31) * 4 + F.wave) : (F.vcu * NWAVES + F.wave);
    const int stride = b256 ? 1024 : F.G * NWAVES;
    if (b256 && F.wave >= 4) return;
    for (; tile < M / 16; tile += stride) {
        const int token = tile * 16 + c16;
        const _Float16* ap = W1G + (size_t)c16 * 1024 + 8 * kq; const _Float16* bp = XH + (size_t)token * D + 8 * kq;
        pg8::f32x4 acc[4];
#pragma unroll
        for (int i = 0; i < 4; ++i) acc[i] = (pg8::f32x4){0.f, 0.f, 0.f, 0.f};
#pragma unroll 2
        for (int s8 = 0; s8 < 4; ++s8) {
            pg8::half8_t av[8], bv[8];
#pragma unroll
            for (int i = 0; i < 8; ++i) { av[i] = *(const pg8::half8_t*)(ap + 32 * (8 * s8 + i)); bv[i] = *(const pg8::half8_t*)(bp + 32 * (8 * s8 + i)); }
#pragma unroll
            for (int i = 0; i < 8; ++i) acc[i & 3] = __builtin_amdgcn_mfma_f32_16x16x32_f16(av[i], bv[i], acc[i & 3], 0, 0, 0);
        }
        const float rs = pg8::row_rstd(SS, token);
        const pg8::f32x4 o = ((acc[0] + acc[1]) + (acc[2] + acc[3])) * rs;
        *(pg8::f32x4*)(T16 + (size_t)token * 16 + 4 * kq) = o;
    }
}
typedef short bf16x8_t __attribute__((ext_vector_type(8)));
typedef short s16x4_t __attribute__((ext_vector_type(4)));
typedef float f32x16 __attribute__((ext_vector_type(16)));
__device__ __forceinline__ s16x4_t lds_tr(const LAS unsigned char* p) { return __builtin_bit_cast(s16x4_t, __builtin_amdgcn_ds_read_tr16_b64_v4i16((LAS s16x4_t*)p)); }
__device__ __forceinline__ bf16x8_t cat44(s16x4_t lo, s16x4_t hi) { return (bf16x8_t){lo[0], lo[1], lo[2], lo[3], hi[0], hi[1], hi[2], hi[3]}; }
__device__ __forceinline__ bf16x8_t packf8(const float* v) { const pg8::u32x4 w = pg8::pack8(v); return __builtin_bit_cast(bf16x8_t, w); }
__device__ __forceinline__ bf16 cvt1(float x) { return (bf16)(pg8::cvt_pk_bf16(x, 0.f) & 0xffffu); }
__device__ __forceinline__ int crow(int r, int hi) { return (r & 3) + 8 * (r >> 2) + 4 * hi; }

constexpr int MOBA_VP = 192;
__device__ __forceinline__ void moba_mfma(Frame& F) {
    const bf16* Qg = F_RA; const bf16* Kg = Qg + 8 * Mi; const bf16* Vg = Qg + 16 * Mi; bf16* CAT = F_CAT; const float* KMP = F_KMP;
    const int tid = F.tid, lane = F.lane, w = F.wave, r32 = lane & 31, h = lane >> 5;
    const float C2 = 0.125f * 1.4426950408889634f;
    const int srow = tid >> 3, sch = tid & 7;
    const unsigned kst = (unsigned)(srow * 128 + ((sch ^ (srow & 7)) << 4)), vst = (unsigned)(srow * MOBA_VP + sch * 16);
    const int tq = (lane & 15) >> 2, tp = lane & 3, tblk = (lane >> 4) & 1;
    for (int wgu = F.vcu; wgu < 256; wgu += F.G) {
        const int b = wgu >> 5, head = (wgu >> 2) & 7, s = wgu & 3;
        for (int half = 0; half < 2; ++half) {
            const int qb = half == 0 ? 7 - s : s;
            const int token = b * SEQ + qb * 256 + 32 * w + r32;
            const bf16* qrow = Qg + (size_t)token * 512 + head * 64;
            bf16x8_t qf[4];
#pragma unroll
            for (int s4 = 0; s4 < 4; ++s4) qf[s4] = *(const bf16x8_t*)(qrow + 16 * s4 + 8 * h);
            const int nt = 2 * (qb + 1);
            const bf16* kbase = Kg + (size_t)(b * SEQ + srow) * 512 + head * 64 + sch * 8;
            const bf16* vbase = Vg + (size_t)(b * SEQ + srow) * 512 + head * 64 + sch * 8;
#define MOBA_LD(T, A0, A1, B0, B1) do { A0 = *(const v4u*)(kbase + (size_t)(T) * 128 * 512); A1 = *(const v4u*)(kbase + (size_t)((T) * 128 + 64) * 512); \
                                        B0 = *(const v4u*)(vbase + (size_t)(T) * 128 * 512); B1 = *(const v4u*)(vbase + (size_t)((T) * 128 + 64) * 512); } while (0)
            v4u ka0, ka1, va0, va1, kb0 = {0u, 0u, 0u, 0u}, kb1 = kb0, vb0 = kb0, vb1 = kb0;
            MOBA_LD(0, ka0, ka1, va0, va1);
            if (nt > 1) MOBA_LD(1, kb0, kb1, vb0, vb1);
            float g[7];
#pragma unroll
            for (int j = 0; j < 7; ++j) {
                g[j] = -1e30f;
                if (j < qb) {
                    const float* k0 = KMP + (size_t)((b * 8 + j) * 2) * 512 + head * 64; float part = 0.f;
#pragma unroll
                    for (int s4 = 0; s4 < 4; ++s4) {
                        const f32x4 a0 = *(const f32x4*)(k0 + 16 * s4 + 8 * h), a1 = *(const f32x4*)(k0 + 16 * s4 + 8 * h + 4);
                        const f32x4 b0 = *(const f32x4*)(k0 + 512 + 16 * s4 + 8 * h), b1 = *(const f32x4*)(k0 + 512 + 16 * s4 + 8 * h + 4);
#pragma unroll
                        for (int e = 0; e < 4; ++e) { part += bf1((bf16)qf[s4][e]) * (a0[e] + b0[e]); part += bf1((bf16)qf[s4][4 + e]) * (a1[e] + b1[e]); }
                    }
                    g[j] = part + __shfl_xor(part, 32);
                }
            }
            unsigned selm = 0;
#pragma unroll
            for (int j = 0; j < 7; ++j) if (j < qb) { int cnt = 0;
#pragma unroll
                for (int jj = 0; jj < 7; ++jj) if (jj != j && jj < qb) cnt += (g[jj] > g[j] || (g[jj] == g[j] && jj < j)) ? 1 : 0;
                if (cnt < 3) selm |= 1u << j; }
            float mrun = -1e30f, lrun = 0.f; f32x16 o[2];
#pragma unroll
            for (int r = 0; r < 16; ++r) { o[0][r] = 0.f; o[1][r] = 0.f; }
#define MOBA_ST(BUF, A0, A1, B0, B1) do { *(LAS v4u*)(F.lds + (BUF) + kst) = A0; *(LAS v4u*)(F.lds + (BUF) + 8192 + kst) = A1; \
                                          *(LAS v4u*)(F.lds + (BUF) + 16384 + vst) = B0; *(LAS v4u*)(F.lds + (BUF) + 16384 + 64 * MOBA_VP + vst) = B1; } while (0)
            MOBA_ST(0, ka0, ka1, va0, va1);
            __syncthreads();
            int bcur = 0;
            for (int tt = 0; tt < nt; ++tt) {
                const int j = tt >> 1, kt2 = tt & 1;
                const int bnxt = bcur == 81920 ? 0 : bcur + 40960;
                if (tt + 2 < nt) MOBA_LD(tt + 2, ka0, ka1, va0, va1);
                if (tt + 1 < nt) MOBA_ST(bnxt, kb0, kb1, vb0, vb1);
                const bool own = (j == qb);
                const bool mysel = own || ((selm >> j) & 1u);
                int nact = 4;
                if (own) { nact = w - 4 * kt2 + 1; nact = nact < 0 ? 0 : (nact > 4 ? 4 : nact); }
                else if (__ballot(mysel) == 0ull) nact = 0;
                if (nact > 0) {
                    const LAS unsigned char* kb = F.lds + bcur; const LAS unsigned char* vb = F.lds + bcur + 16384;
                    f32x16 st[4];
                    __builtin_amdgcn_s_setprio(1);
#pragma unroll
                    for (int mt = 0; mt < 4; ++mt) {
                        if (mt < nact) {
#pragma unroll
                            for (int r = 0; r < 16; ++r) st[mt][r] = 0.f;
                            const int row = 32 * mt + r32;
#pragma unroll
                            for (int s4 = 0; s4 < 4; ++s4) { const bf16x8_t kf = *(const LAS bf16x8_t*)(kb + row * 128 + (((2 * s4 + h) ^ (row & 7)) << 4));
                                st[mt] = __builtin_amdgcn_mfma_f32_32x32x16_bf16(kf, qf[s4], st[mt], 0, 0, 0); }
                            if (!own) { if (!mysel) {
#pragma unroll
                                for (int r = 0; r < 16; ++r) st[mt][r] = -INFINITY; } }
                            else if (128 * kt2 + 32 * mt + 31 > 32 * w) {
                                const int qi = 32 * w + r32;
#pragma unroll
                                for (int r = 0; r < 16; ++r) if (128 * kt2 + 32 * mt + crow(r, h) > qi) st[mt][r] = -INFINITY;
                            }
                        } else {
#pragma unroll
                            for (int r = 0; r < 16; ++r) st[mt][r] = -INFINITY;
                        }
                    }
                    __builtin_amdgcn_s_setprio(0);
                    float mx = fmaxf(fmaxf(st[0][0], st[1][0]), fmaxf(st[2][0], st[3][0]));
#pragma unroll
                    for (int r = 1; r < 16; ++r) mx = fmaxf(mx, fmaxf(fmaxf(st[0][r], st[1][r]), fmaxf(st[2][r], st[3][r])));
                    mx = fmaxf(mx, __shfl_xor(mx, 32));
                    const float mnew = fmaxf(mrun, mx);
                    if (__ballot(mnew > mrun) != 0ull) {
                        const float alpha = __builtin_amdgcn_exp2f((mrun - mnew) * C2);
                        lrun *= alpha;
#pragma unroll
                        for (int r = 0; r < 16; ++r) { o[0][r] *= alpha; o[1][r] *= alpha; }
                    }
                    mrun = mnew; const float mc = mnew * C2;
                    float psum = 0.f;
#pragma unroll
                    for (int mt = 0; mt < 4; ++mt)
#pragma unroll
                        for (int r = 0; r < 16; ++r) { const float p = __builtin_amdgcn_exp2f(__builtin_fmaf(st[mt][r], C2, -mc)); st[mt][r] = p; psum += p; }
                    lrun += psum;
                    __builtin_amdgcn_s_setprio(1);
#pragma unroll
                    for (int s8 = 0; s8 < 8; ++s8) {
                        const int mt = s8 >> 1, rb = 8 * (s8 & 1);
                        if (mt < nact) {
                            float pv8[8];
#pragma unroll
                            for (int e = 0; e < 8; ++e) pv8[e] = st[mt][rb + e];
                            const bf16x8_t pf = packf8(pv8);
                            const int krow = 32 * mt + 16 * (s8 & 1) + 4 * h + tq;
#pragma unroll
                            for (int t = 0; t < 2; ++t) {
                                const LAS unsigned char* ap = vb + krow * MOBA_VP + (32 * t + 16 * tblk + 4 * tp) * 2;
                                const bf16x8_t vf = cat44(lds_tr(ap), lds_tr(ap + 8 * MOBA_VP));
                                o[t] = __builtin_amdgcn_mfma_f32_32x32x16_bf16(vf, pf, o[t], 0, 0, 0);
                            }
                        }
                    }
                    __builtin_amdgcn_s_setprio(0);
                }
                kb0 = ka0; kb1 = ka1; vb0 = va0; vb1 = va1; bcur = bnxt;
                __syncthreads();
            }
#undef MOBA_LD
#undef MOBA_ST
            const float ltot = lrun + __shfl_xor(lrun, 32), inv = 1.0f / ltot;
            bf16* orow = CAT + (size_t)token * 1024 + head * 64;
#pragma unroll
            for (int t = 0; t < 2; ++t)
#pragma unroll
                for (int rg = 0; rg < 4; ++rg) { v2u wv; wv.x = pg8::cvt_pk_bf16(o[t][4 * rg] * inv, o[t][4 * rg + 1] * inv); wv.y = pg8::cvt_pk_bf16(o[t][4 * rg + 2] * inv, o[t][4 * rg + 3] * inv);
                    *(v2u*)(orow + 32 * t + 8 * rg + 4 * h) = wv; }
        }
    }
}
__device__ __forceinline__ void gmlp_mfma(Frame& F, int li) {
    const bf16* U = F_RA + 24 * Mi; const bf16* VN = F_RA + 32 * Mi; bf16* CAT = F_CAT;
    const bf16* WSB = F.wsh(WS_WSB) + (size_t)li * 8 * 128 * 128; const float* bs = F.inf(I_EV_B_S) + (size_t)li * 8 * 128;
    const int lane = F.lane, r32 = lane & 31, h = lane >> 5;
    const int tq = (lane & 15) >> 2, tp = lane & 3, tblk = (lane >> 4) & 1;
    const int pr = F.wave >> 1, sub = F.wave & 1;
    LAS unsigned char* wl = F.lds + pr * 16384;
    for (int wgu = F.vcu; wgu < 256; wgu += F.G) {
        const int uid = (wgu & 31) * 4 + pr, chunk = (wgu >> 5) * 16 + (uid >> 3), g = uid & 7; const int tok0 = chunk * 128;
        v4u vimg[8];
#pragma unroll
        for (int i = 0; i < 8; ++i) { const int n = lane + 64 * (2 * i + sub), row = n >> 3, ch = n & 7; vimg[i] = *(const v4u*)(VN + (size_t)(tok0 + row) * 512 + g * 64 + ch * 8); }
        const bf16* wsg = WSB + (size_t)g * 128 * 128;
        bf16x8_t bq[2][8];
#pragma unroll
        for (int ii = 0; ii < 2; ++ii) {
            const int itile = ii == 0 ? sub : 3 - sub, icol = 32 * itile + r32, nks = 2 * itile + 2;
#pragma unroll
            for (int ks = 0; ks < 8; ++ks) { bq[ii][ks] = (bf16x8_t){0, 0, 0, 0, 0, 0, 0, 0}; if (ks < nks) bq[ii][ks] = *(const bf16x8_t*)(wsg + (size_t)icol * 128 + 16 * ks + 8 * h); }
        }
#pragma unroll
        for (int i = 0; i < 8; ++i) { const int n = lane + 64 * (2 * i + sub), row = n >> 3, ch = n & 7; *(LAS v4u*)(wl + row * 128 + ch * 16) = vimg[i]; }
        __syncthreads();
#pragma unroll
        for (int ii = 0; ii < 2; ++ii) {
            const int itile = ii == 0 ? sub : 3 - sub, nks = 2 * itile + 2;
            const int icol = 32 * itile + r32;
            const float bsv = bs[g * 128 + icol];
            const size_t tok = (size_t)(tok0 + icol);
            v2u uw[2][4];
#pragma unroll
            for (int t = 0; t < 2; ++t)
#pragma unroll
                for (int rg = 0; rg < 4; ++rg) uw[t][rg] = *(const v2u*)(U + tok * 512 + g * 64 + 32 * t + 8 * rg + 4 * h);
            f32x16 acc[2];
#pragma unroll
            for (int r = 0; r < 16; ++r) { acc[0][r] = 0.f; acc[1][r] = 0.f; }
#pragma unroll
            for (int ks = 0; ks < 8; ++ks) {
                if (ks < nks) {
#pragma unroll
                    for (int t = 0; t < 2; ++t) {
                        const LAS unsigned char* ap = wl + (16 * ks + 8 * h + tq) * 128 + (32 * t + 16 * tblk + 4 * tp) * 2;
                        const bf16x8_t af = cat44(lds_tr(ap), lds_tr(ap + 4 * 128));
                        acc[t] = __builtin_amdgcn_mfma_f32_32x32x16_bf16(af, bq[ii][ks], acc[t], 0, 0, 0);
                    }
                }
            }
#pragma unroll
            for (int t = 0; t < 2; ++t)
#pragma unroll
                for (int rg = 0; rg < 4; ++rg) {
                    const int d = 32 * t + 8 * rg + 4 * h;
                    v2u wv; wv.x = pg8::cvt_pk_bf16(bflo(uw[t][rg].x) * (acc[t][4 * rg] + bsv), bfhi(uw[t][rg].x) * (acc[t][4 * rg + 1] + bsv));
                    wv.y = pg8::cvt_pk_bf16(bflo(uw[t][rg].y) * (acc[t][4 * rg + 2] + bsv), bfhi(uw[t][rg].y) * (acc[t][4 * rg + 3] + bsv));
                    *(v2u*)(CAT + tok * 1024 + 512 + g * 64 + d) = wv;
                }
        }
        __syncthreads();
    }
}
__device__ __forceinline__ void xattn_dma_image(Frame& F, const bf16* img) {
    unsigned voff = (unsigned)F.tid * 16u; asm volatile("" : "+v"(voff));
    const unsigned long long pv = (unsigned long long)img;
    unsigned plo = (unsigned)__builtin_amdgcn_readfirstlane((int)(unsigned)pv); const unsigned phi = (unsigned)__builtin_amdgcn_readfirstlane((int)(unsigned)(pv >> 32));
#pragma unroll
    for (int i = 0; i < 16; ++i) { const unsigned char* p = (const unsigned char*)(((unsigned long long)phi << 32) | plo);
        __builtin_amdgcn_global_load_lds((const unsigned*)(p + voff), (LAS unsigned*)(F.lds + F.wave * 1024 + i * 8192), 16, 0, 0);
        plo += 8192u; asm volatile("" : "+s"(plo)); }
}
__device__ __forceinline__ void xattn_mfma(Frame& F, int l, const pg8::StaticOrder& SO) {
    const bf16* QX = F_RA; bf16* CAT = F_CAT;
    const bf16* KX = F_KXN + (size_t)l * 32 * 65536; const bf16* VXp = F_VX + (size_t)l * 32 * 65536;
    const int lane = F.lane, w = F.wave, r32 = lane & 31, h = lane >> 5;
    const int tq = (lane & 15) >> 2, tp = lane & 3, tblk = (lane >> 4) & 1;
    pg8::Unit uu;
    for (int ui = 0; SO.next(ui, uu); ++ui) {
        const int pm = uu.pm, head = uu.pn, b = pm >> 3;
        const int token = pm * 256 + 32 * w + r32;
        xattn_dma_image(F, KX + (size_t)(b * 4 + head) * 65536);
        const bf16* qtile = QX + (size_t)(((pm * 4 + head) * 8 + w) * 16) * 512 + r32 * 16 + 8 * h;
        float ss = 0.f;
        f32x16 st[8];
#pragma unroll
        for (int mt = 0; mt < 8; ++mt)
#pragma unroll
            for (int r = 0; r < 16; ++r) st[mt][r] = 0.f;
        asm volatile("s_waitcnt vmcnt(0)" ::: "memory");
        __syncthreads();
#pragma unroll
        for (int qh = 0; qh < 2; ++qh) {
            bf16x8_t qf[8];
#pragma unroll
            for (int s = 0; s < 8; ++s) { qf[s] = *(const bf16x8_t*)(qtile + (8 * qh + s) * 512);
#pragma unroll
                for (int e = 0; e < 8; ++e) { const float qv = bf1((bf16)qf[s][e]); ss += qv * qv; } }
            __builtin_amdgcn_s_setprio(1);
#pragma unroll
            for (int mt = 0; mt < 8; ++mt) {
                const int row = 32 * mt + r32;
#pragma unroll
                for (int s = 0; s < 8; ++s) { const bf16x8_t kf = *(const LAS bf16x8_t*)(F.lds + row * 512 + (((16 * qh + 2 * s + h) ^ (row & 15)) << 4));
                    st[mt] = __builtin_amdgcn_mfma_f32_32x32x16_bf16(kf, qf[s], st[mt], 0, 0, 0); }
            }
            __builtin_amdgcn_s_setprio(0);
            asm volatile("" ::: "memory");
        }
        ss += __shfl_xor(ss, 32);
        const float cs = __builtin_amdgcn_rsqf(ss * (1.0f / 256.0f) + EPSF) * (0.0625f * 1.4426950408889634f);
        __syncthreads();
        xattn_dma_image(F, VXp + (size_t)(b * 4 + head) * 65536);
        float mx = st[0][0];
#pragma unroll
        for (int mt = 0; mt < 8; ++mt)
#pragma unroll
            for (int r = 0; r < 16; ++r) mx = fmaxf(mx, st[mt][r]);
        mx = fmaxf(mx, __shfl_xor(mx, 32));
        const float mc = mx * cs; float psum = 0.f;
        bf16x8_t pf[16];
#pragma unroll
        for (int mt = 0; mt < 8; ++mt) {
#pragma unroll
            for (int r = 0; r < 16; ++r) { const float p = __builtin_amdgcn_exp2f(__builtin_fmaf(st[mt][r], cs, -mc)); st[mt][r] = p; psum += p; }
#pragma unroll
            for (int hh = 0; hh < 2; ++hh) { float pv8[8];
#pragma unroll
                for (int e = 0; e < 8; ++e) pv8[e] = st[mt][8 * hh + e];
                pf[2 * mt + hh] = packf8(pv8); }
        }
        psum += __shfl_xor(psum, 32);
        const float inv = 1.0f / psum;
        asm volatile("s_waitcnt vmcnt(0)" ::: "memory");
        __syncthreads();
        v2u opk[2][16];
#pragma unroll
        for (int dh = 0; dh < 2; ++dh) {
            f32x16 o[4];
#pragma unroll
            for (int t = 0; t < 4; ++t)
#pragma unroll
                for (int r = 0; r < 16; ++r) o[t][r] = 0.f;
            int vrow = (4 * h + tq) * 512 + 8 * (tp & 1), vch = 2 * tblk + (tp >> 1), vx = tq << 2; asm volatile("" : "+v"(vrow), "+v"(vch), "+v"(vx));
            __builtin_amdgcn_s_setprio(1);
#pragma unroll
            for (int s = 0; s < 16; ++s) {
#pragma unroll
                for (int t = 0; t < 4; ++t) {
                    const LAS unsigned char* ap = F.lds + vrow + (16 * s) * 512 + (((16 * dh + 4 * t + vch) ^ vx) << 4);
                    const bf16x8_t vf = cat44(lds_tr(ap), lds_tr(ap + 8 * 512));
                    o[t] = __builtin_amdgcn_mfma_f32_32x32x16_bf16(vf, pf[s], o[t], 0, 0, 0);
                }
            }
            __builtin_amdgcn_s_setprio(0);
#pragma unroll
            for (int t = 0; t < 4; ++t)
#pragma unroll
                for (int rg = 0; rg < 4; ++rg) { opk[dh][4 * t + rg].x = pg8::cvt_pk_bf16(o[t][4 * rg] * inv, o[t][4 * rg + 1] * inv); opk[dh][4 * t + rg].y = pg8::cvt_pk_bf16(o[t][4 * rg + 2] * inv, o[t][4 * rg + 3] * inv); }
        }
        __syncthreads();
        { LAS unsigned char* og_ = F.lds + w * 16384;
          int lz = F.lane; asm volatile("" : "+v"(lz));
          const int rr = lz & 31, hz = lz >> 5;
#pragma unroll
          for (int dh = 0; dh < 2; ++dh)
#pragma unroll
              for (int t = 0; t < 4; ++t)
#pragma unroll
                  for (int rg = 0; rg < 4; ++rg) { const int ch = 16 * dh + 4 * t + rg;
                      *(LAS v2u*)(og_ + rr * 512 + ((ch ^ rr) << 4) + 8 * hz) = opk[dh][4 * t + rg]; }
          LDS_WAIT(); asm volatile("" ::: "memory");
          bf16* obase = CAT + (size_t)(pm * 256 + 32 * w) * 1024 + head * 256;
#pragma unroll
          for (int i = 0; i < 16; ++i) { const int row = 2 * i + hz, ch = rr;
              *(v4u*)(obase + (unsigned)(row * 1024 + ch * 8)) = *(const LAS v4u*)(og_ + row * 512 + ((ch ^ row) << 4)); }
          LDS_WAIT(); asm volatile("" ::: "memory"); }
        __syncthreads();
    }
}

constexpr int GL_QIN = 0, GL_KIN = 16384, GL_KST = 32768, GL_KSTP = 320, GL_VCH = 53248, GL_VP = 576, GL_TOT = 90112, GL_DEC = 92160, GL_T16 = 92672;
constexpr size_t WS_DEC = WS_KMP + 512 * 1024;
__device__ __forceinline__ void gla_g1(Frame& F, int li) {
    bf16* PROJ = F_RA; bf16* QG = F_RA + 48 * Mi; bf16* CAT = F_CAT; const float* T16 = F_T16; float* DS = F_OUT; float* DECG = F.wsf(WS_DEC);
    const float* w2 = F.inf(I_OD_W_G2) + (size_t)li * 16 * 512; const float* bg = F.inf(I_OD_B_G) + (size_t)li * 512;
    const int tid = F.tid, w = F.wave;
    const int d = tid & 127, iq = __builtin_amdgcn_readfirstlane(tid >> 7);
    LAS unsigned char* L = F.lds;
    LAS float* TOT = (LAS float*)(L + GL_TOT); LAS float* DECL = (LAS float*)(L + GL_DEC);
    for (int u = F.vcu; u < 256; u += F.G) {
        const int b = u >> 5, hh = (u >> 3) & 3, sc = u & 7; const int T0 = b * SEQ + sc * 256;
        float w2c[16];
#pragma unroll
        for (int r = 0; r < 16; ++r) w2c[r] = w2[r * 512 + hh * 128 + d];
        const float bgc = bg[hh * 128 + d];
        float Bprev = 0.f;
        { const int n = tid; const f32x4* src = (const f32x4*)(T16 + (size_t)T0 * 16);
#pragma unroll
          for (int i2 = 0; i2 < 2; ++i2) *(LAS f32x4*)(L + GL_T16 + (n + 512 * i2) * 16) = src[n + 512 * i2]; }
        __syncthreads();
        f32x16 S[4];
#pragma unroll
        for (int t = 0; t < 4; ++t)
#pragma unroll
            for (int r = 0; r < 16; ++r) S[t][r] = 0.f;
        unsigned short qraw[16], kraw[16]; v4u vreg[4];
#define GL_LOADS_Q(TOK) do { const bf16* qb_ = PROJ + (size_t)((TOK) + 16 * iq) * OD_IN + hh * 128;     \
        _Pragma("unroll") for (int ii = 0; ii < 16; ++ii) { qraw[ii] = qb_[(unsigned)(ii * OD_IN + d)]; kraw[ii] = qb_[(unsigned)(ii * OD_IN + 512 + d)]; } } while (0)
#define GL_LOADS(TOK) do { const bf16* vb_ = PROJ + (size_t)(TOK) * OD_IN + 1024 + hh * 256; \
        _Pragma("unroll") for (int i2 = 0; i2 < 4; ++i2) { const int n_ = tid + 512 * i2; vreg[i2] = *(const v4u*)(vb_ + (unsigned)((n_ >> 5) * OD_IN + (n_ & 31) * 8)); } } while (0)
        GL_LOADS(T0);
        for (int c = 0; c < 4; ++c) {
            const int tok0 = T0 + 64 * c;
            GL_LOADS_Q(tok0);
            float bl[16]; float run = 0.f;
#pragma unroll
            for (int ii = 0; ii < 16; ++ii) {
                const LAS f32x4* t16 = (const LAS f32x4*)(L + GL_T16 + (64 * c + 16 * iq + ii) * 64); float z = bgc;
#pragma unroll
                for (int r4 = 0; r4 < 4; ++r4) { const f32x4 tv = t16[r4]; z += tv[0] * w2c[4 * r4] + tv[1] * w2c[4 * r4 + 1] + tv[2] * w2c[4 * r4 + 2] + tv[3] * w2c[4 * r4 + 3]; }
                const float ls = fminf(z, 0.f) - __logf(1.0f + __expf(-fabsf(z)));
                run += ls * (1.0f / 16.0f); bl[ii] = run;
            }
            TOT[iq * 128 + d] = run;
#pragma unroll
            for (int i2 = 0; i2 < 4; ++i2) { const int n = tid + 512 * i2, row = n >> 5, ch = n & 31; *(LAS v4u*)(L + GL_VCH + row * GL_VP + ch * 16) = vreg[i2]; }
            __syncthreads();
            float off = 0.f, blast = 0.f;
#pragma unroll
            for (int q4 = 0; q4 < 4; ++q4) { const float tv = TOT[q4 * 128 + d]; blast += tv; if (q4 < iq) off += tv; }
            const float eB = __expf(Bprev), eL = __expf(blast);
#pragma unroll
            for (int ii = 0; ii < 16; ++ii) {
                const int row = 16 * iq + ii;
                const float bb = off + bl[ii];
                const float qv = bf1(qraw[ii]), kv = bf1(kraw[ii]);
                const float e = __expf(bb), ei = __builtin_amdgcn_rcpf(e);
                const unsigned swz = (unsigned)(row * 256 + ((((d >> 3) ^ (row & 15)) << 4) | ((d & 7) * 2)));
                *(LAS bf16*)(L + GL_QIN + swz) = cvt1(qv * e);
                *(LAS bf16*)(L + GL_KIN + swz) = cvt1(kv * ei);
                *(LAS bf16*)(L + GL_KST + row * GL_KSTP + d * 2) = cvt1(kv * ei * eL);
                QG[(size_t)(tok0 + row) * 512 + hh * 128 + d] = cvt1(qv * e * eB);
            }
            if (iq == 0) DECL[d] = eL;
            Bprev += blast;
            __syncthreads();
            if (c < 3) GL_LOADS(tok0 + 64);
            int lane = F.lane; asm volatile("" : "+v"(lane));
            const int r32 = lane & 31, h = lane >> 5, tq = (lane & 15) >> 2, tp = lane & 3, tblk = (lane >> 4) & 1;
            bf16x8_t aT[3][2];
#pragma unroll
            for (int tile = 0; tile < 3; ++tile) {
                const int jt = tile == 2 ? 1 : 0, it = tile == 0 ? 0 : 1;
                f32x16 a;
#pragma unroll
                for (int r = 0; r < 16; ++r) a[r] = 0.f;
                const int rowj = 32 * jt + r32, rowi = 32 * it + r32;
#pragma unroll
                for (int s8 = 0; s8 < 8; ++s8) {
                    const bf16x8_t kf = *(const LAS bf16x8_t*)(L + GL_KIN + rowj * 256 + (((2 * s8 + h) ^ (rowj & 15)) << 4));
                    const bf16x8_t qf = *(const LAS bf16x8_t*)(L + GL_QIN + rowi * 256 + (((2 * s8 + h) ^ (rowi & 15)) << 4));
                    a = __builtin_amdgcn_mfma_f32_32x32x16_bf16(kf, qf, a, 0, 0, 0);
                }
                if (jt == it) {
#pragma unroll
                    for (int r = 0; r < 16; ++r) if (crow(r, h) > r32) a[r] = 0.f;
                }
                float p8[8];
#pragma unroll
                for (int e = 0; e < 8; ++e) p8[e] = a[e];
                aT[tile][0] = packf8(p8);
#pragma unroll
                for (int e = 0; e < 8; ++e) p8[e] = a[8 + e];
                aT[tile][1] = packf8(p8);
            }
#pragma unroll
            for (int it = 0; it < 2; ++it) {
                f32x16 o;
#pragma unroll
                for (int r = 0; r < 16; ++r) o[r] = 0.f;
#pragma unroll
                for (int jt = 0; jt <= it; ++jt) {
                    const int tile = jt == 0 ? it : 2;
#pragma unroll
                    for (int s2 = 0; s2 < 2; ++s2) {
                        const LAS unsigned char* ap = L + GL_VCH + (32 * jt + 16 * s2 + 4 * h + tq) * GL_VP + (32 * w + 16 * tblk + 4 * tp) * 2;
                        const bf16x8_t vf = cat44(lds_tr(ap), lds_tr(ap + 8 * GL_VP));
                        o = __builtin_amdgcn_mfma_f32_32x32x16_bf16(vf, aT[tile][s2], o, 0, 0, 0);
                    }
                }
                const int rowi = 32 * it + r32;
#pragma unroll
                for (int dkt = 0; dkt < 4; ++dkt)
#pragma unroll
                    for (int s2 = 0; s2 < 2; ++s2) {
                        float p8[8];
#pragma unroll
                        for (int e = 0; e < 8; ++e) p8[e] = S[dkt][8 * s2 + e];
                        const bf16x8_t sf = packf8(p8);
                        const int chk = 4 * dkt + 2 * s2;
                        const s16x4_t q0 = *(const LAS s16x4_t*)(L + GL_QIN + rowi * 256 + ((chk ^ (rowi & 15)) << 4) + 8 * h);
                        const s16x4_t q1 = *(const LAS s16x4_t*)(L + GL_QIN + rowi * 256 + (((chk + 1) ^ (rowi & 15)) << 4) + 8 * h);
                        o = __builtin_amdgcn_mfma_f32_32x32x16_bf16(sf, cat44(q0, q1), o, 0, 0, 0);
                    }
                bf16* orow = CAT + (size_t)(tok0 + rowi) * 1024 + hh * 256 + 32 * w + 4 * h;
#pragma unroll
                for (int rg = 0; rg < 4; ++rg) { v2u wv; wv.x = pg8::cvt_pk_bf16(o[4 * rg], o[4 * rg + 1]); wv.y = pg8::cvt_pk_bf16(o[4 * rg + 2], o[4 * rg + 3]); *(v2u*)(orow + 8 * rg) = wv; }
            }
#pragma unroll
            for (int dkt = 0; dkt < 4; ++dkt)
#pragma unroll
                for (int r = 0; r < 16; ++r) S[dkt][r] *= DECL[32 * dkt + crow(r, h)];
#pragma unroll
            for (int s4 = 0; s4 < 4; ++s4) {
                const LAS unsigned char* bp = L + GL_VCH + (16 * s4 + 8 * h + tq) * GL_VP + (32 * w + 16 * tblk + 4 * tp) * 2;
                const bf16x8_t vfb = cat44(lds_tr(bp), lds_tr(bp + 4 * GL_VP));
#pragma unroll
                for (int dkt = 0; dkt < 4; ++dkt) {
                    const LAS unsigned char* ak = L + GL_KST + (16 * s4 + 8 * h + tq) * GL_KSTP + (32 * dkt + 16 * tblk + 4 * tp) * 2;
                    const bf16x8_t kfa = cat44(lds_tr(ak), lds_tr(ak + 4 * GL_KSTP));
                    S[dkt] = __builtin_amdgcn_mfma_f32_32x32x16_bf16(kfa, vfb, S[dkt], 0, 0, 0);
                }
            }
            __syncthreads();
        }
        if (iq == 0) DECG[u * 128 + d] = __expf(Bprev);
#undef GL_LOADS
#undef GL_LOADS_Q
        { bf16* dsu = (bf16*)DS + (size_t)u * 32768 + (size_t)w * 4096 + (size_t)F.lane * 16;
#pragma unroll
          for (int dkt = 0; dkt < 4; ++dkt) {
              float t8[8];
#pragma unroll
              for (int hx = 0; hx < 2; ++hx) {
#pragma unroll
                  for (int e = 0; e < 8; ++e) t8[e] = S[dkt][8 * hx + e];
                  *(pg8::u32x4*)(dsu + dkt * 1024 + 8 * hx) = pg8::pack8(t8); } } }
    }
}
__device__ __forceinline__ void gla_g2(Frame& F, int li) {
    const bf16* PROJ = F_RA; const bf16* QG = F_RA + 48 * Mi; bf16* CAT = F_CAT; const bf16* DS = (const bf16*)F_OUT; const float* DECG = F.wsf(WS_DEC);
    const float* og = F.inf(I_OD_O_GAIN) + (size_t)li * 1024;
    const int w = F.wave;
    LAS float* red = (LAS float*)F.lds;
    for (int u = F.vcu; u < 256; u += F.G) {
        int lane = F.lane; asm volatile("" : "+v"(lane));
        const int r32 = lane & 31, h = lane >> 5;
        const int b = u >> 5, hh = (u >> 3) & 3, sc = u & 7; const int T0 = b * SEQ + sc * 256;
        f32x16 S[4], cur[4];
#pragma unroll
        for (int t = 0; t < 4; ++t)
#pragma unroll
            for (int r = 0; r < 16; ++r) { S[t][r] = 0.f; cur[t][r] = 0.f; }
        unsigned lo_ = (unsigned)(w * 4096 + lane * 16); asm volatile("" : "+v"(lo_));
#define G2_LOAD(DST, PTR) do { _Pragma("unroll") for (int dkt = 0; dkt < 4; ++dkt) _Pragma("unroll") for (int hx = 0; hx < 2; ++hx) { const v4u t4 = *(const v4u*)((PTR) + dkt * 1024 + 8 * hx); \
            DST[dkt][8 * hx] = bflo(t4.x); DST[dkt][8 * hx + 1] = bfhi(t4.x); DST[dkt][8 * hx + 2] = bflo(t4.y); DST[dkt][8 * hx + 3] = bfhi(t4.y); \
            DST[dkt][8 * hx + 4] = bflo(t4.z); DST[dkt][8 * hx + 5] = bfhi(t4.z); DST[dkt][8 * hx + 6] = bflo(t4.w); DST[dkt][8 * hx + 7] = bfhi(t4.w); } } while (0)
        if (sc > 0) { const bf16* dsu = DS + (size_t)(u - sc) * 32768 + lo_; G2_LOAD(cur, dsu); }
        for (int cp = 0; cp < sc; ++cp) {
            const int up = u - sc + cp; const float* dcu = DECG + up * 128 + 4 * h;
            f32x16 nxt[4];
            asm volatile("" : "+v"(lo_));
            if (cp + 1 < sc) { const bf16* dsn = DS + (size_t)(up + 1) * 32768 + lo_; G2_LOAD(nxt, dsn); }
            else {
#pragma unroll
                for (int dkt = 0; dkt < 4; ++dkt)
#pragma unroll
                    for (int r = 0; r < 16; ++r) nxt[dkt][r] = 0.f; }
#pragma unroll
            for (int dkt = 0; dkt < 4; ++dkt)
#pragma unroll
                for (int r4 = 0; r4 < 4; ++r4) { const f32x4 d4 = *(const f32x4*)(dcu + 32 * dkt + 8 * r4);
#pragma unroll
                    for (int e = 0; e < 4; ++e) { S[dkt][4 * r4 + e] = d4[e] * S[dkt][4 * r4 + e] + cur[dkt][4 * r4 + e]; cur[dkt][4 * r4 + e] = nxt[dkt][4 * r4 + e]; } }
        }
#undef G2_LOAD
        bf16x8_t sf[4][2];
#pragma unroll
        for (int dkt = 0; dkt < 4; ++dkt)
#pragma unroll
            for (int s2 = 0; s2 < 2; ++s2) { float p8[8];
#pragma unroll
                for (int e = 0; e < 8; ++e) p8[e] = S[dkt][8 * s2 + e];
                sf[dkt][s2] = packf8(p8); }
        f32x4 gv[4];
#pragma unroll
        for (int rg = 0; rg < 4; ++rg) gv[rg] = *(const f32x4*)(og + hh * 256 + 32 * w + 4 * h + 8 * rg);
        LAS unsigned char* GQ = F.lds + 8192; LAS unsigned char* GO = F.lds + 24576; LAS unsigned char* GR = F.lds + 57344;
#pragma unroll 1
        for (int qtr = 0; qtr < 4; ++qtr) {
            const size_t tokQ = (size_t)(T0 + 64 * qtr);
            int tid = F.tid; asm volatile("" : "+v"(tid));
            { v4u qv[2], ov[4], rv[4];
              const bf16* qb_ = QG + tokQ * 512 + hh * 128; const bf16* ob_ = CAT + tokQ * 1024 + hh * 256; const bf16* rb_ = PROJ + tokQ * OD_IN + 2048 + hh * 256;
#pragma unroll
              for (int i = 0; i < 2; ++i) { const int c = tid + 512 * i, row = c >> 4, ch = c & 15; qv[i] = *(const v4u*)(qb_ + (unsigned)(row * 512 + ch * 8)); }
#pragma unroll
              for (int i = 0; i < 4; ++i) { const int c = tid + 512 * i, row = c >> 5, ch = c & 31; ov[i] = *(const v4u*)(ob_ + (unsigned)(row * 1024 + ch * 8)); rv[i] = *(const v4u*)(rb_ + (unsigned)(row * OD_IN + ch * 8)); }
#pragma unroll
              for (int i = 0; i < 2; ++i) { const int c = tid + 512 * i, row = c >> 4, ch = c & 15; *(LAS v4u*)(GQ + row * 256 + ((ch ^ (row & 15)) << 4)) = qv[i]; }
#pragma unroll
              for (int i = 0; i < 4; ++i) { const int c = tid + 512 * i, row = c >> 5, ch = c & 31; *(LAS v4u*)(GO + row * 512 + ((ch ^ (row & 31)) << 4)) = ov[i]; *(LAS v4u*)(GR + row * 512 + ((ch ^ (row & 31)) << 4)) = rv[i]; } }
            __syncthreads();
            f32x16 o[2];
#pragma unroll
            for (int it = 0; it < 2; ++it) {
                const int row = 32 * it + r32;
#pragma unroll
                for (int r = 0; r < 16; ++r) o[it][r] = 0.f;
                if (sc > 0) {
#pragma unroll
                    for (int dkt = 0; dkt < 4; ++dkt)
#pragma unroll
                        for (int s2 = 0; s2 < 2; ++s2) { const int chk = 4 * dkt + 2 * s2;
                            const s16x4_t q0 = *(const LAS s16x4_t*)(GQ + row * 256 + ((chk ^ (row & 15)) << 4) + 8 * h);
                            const s16x4_t q1 = *(const LAS s16x4_t*)(GQ + row * 256 + (((chk + 1) ^ (row & 15)) << 4) + 8 * h);
                            o[it] = __builtin_amdgcn_mfma_f32_32x32x16_bf16(sf[dkt][s2], cat44(q0, q1), o[it], 0, 0, 0); }
                }
                float q = 0.f;
#pragma unroll
                for (int rg = 0; rg < 4; ++rg) { const v2u ow = *(const LAS v2u*)(GO + row * 512 + (((4 * w + rg) ^ (row & 31)) << 4) + 8 * h);
                    o[it][4 * rg] += bflo(ow.x); o[it][4 * rg + 1] += bfhi(ow.x); o[it][4 * rg + 2] += bflo(ow.y); o[it][4 * rg + 3] += bfhi(ow.y); }
#pragma unroll
                for (int r = 0; r < 16; ++r) q += o[it][r] * o[it][r];
                q += __shfl_xor(q, 32);
                if (h == 0) red[w * 64 + row] = q;
            }
            __syncthreads();
#pragma unroll
            for (int it = 0; it < 2; ++it) {
                const int row = 32 * it + r32; float tot = 0.f;
#pragma unroll
                for (int w2_ = 0; w2_ < 8; ++w2_) tot += red[w2_ * 64 + row];
                const float rn = __builtin_amdgcn_rsqf(tot * (1.0f / 256.0f) + EPSF);
#pragma unroll
                for (int rg = 0; rg < 4; ++rg) {
                    const unsigned a = (unsigned)(row * 512 + (((4 * w + rg) ^ (row & 31)) << 4) + 8 * h);
                    const v2u rw = *(const LAS v2u*)(GR + a);
                    const float r0 = bflo(rw.x), r1 = bfhi(rw.x), r2 = bflo(rw.y), r3 = bfhi(rw.y);
                    const float v0 = o[it][4 * rg] * rn * gv[rg][0] * (r0 * __builtin_amdgcn_rcpf(1.0f + __expf(-r0))), v1 = o[it][4 * rg + 1] * rn * gv[rg][1] * (r1 * __builtin_amdgcn_rcpf(1.0f + __expf(-r1)));
                    const float v2 = o[it][4 * rg + 2] * rn * gv[rg][2] * (r2 * __builtin_amdgcn_rcpf(1.0f + __expf(-r2))), v3 = o[it][4 * rg + 3] * rn * gv[rg][3] * (r3 * __builtin_amdgcn_rcpf(1.0f + __expf(-r3)));
                    v2u wv; wv.x = pg8::cvt_pk_bf16(v0, v1); wv.y = pg8::cvt_pk_bf16(v2, v3); *(LAS v2u*)(GO + a) = wv;
                }
            }
            __syncthreads();
#pragma unroll
            for (int i = 0; i < 4; ++i) { const int c = tid + 512 * i, row = c >> 5, ch = c & 31; *(v4u*)(CAT + tokQ * 1024 + hh * 256 + (unsigned)(row * 1024 + ch * 8)) = *(const LAS v4u*)(GO + row * 512 + ((ch ^ (row & 31)) << 4)); }
            __syncthreads();
        }
    }
}

#define XB_TMO      128
#define XB_XCNT(j)  (256  + 64 * (j))
#define XB_XSUB(j)  (1280 + 64 * (j))
#define XB_XGEN(j)  (2304 + 64 * (j))
#define XB_TOP      3328
#define XB_TOPGEN   3392
#define XCD_BAR_WORDS 3456
#define WCNT_WORD 51200
#define XB_SPIN_CAP (1u << 18)
__device__ __forceinline__ unsigned xb_ld(unsigned* p)              { return __hip_atomic_load(p, __ATOMIC_RELAXED, __HIP_MEMORY_SCOPE_AGENT); }
__device__ __forceinline__ unsigned xb_add(unsigned* p, unsigned v) { return __hip_atomic_fetch_add(p, v, __ATOMIC_RELAXED, __HIP_MEMORY_SCOPE_AGENT); }
__device__ __forceinline__ unsigned xb_xcc_id() { return (unsigned)__builtin_amdgcn_s_getreg((3 << 11) | 20) & 0xFu; }
#define XB_SPIN(cond, bar) do { unsigned _sp = 0; while (cond) { __builtin_amdgcn_s_sleep(1); \
    if ((++_sp & 255u) == 0u) { if (xb_ld(&(bar)[XB_TMO])) break; if (_sp > XB_SPIN_CAP) { atomicAdd(&(bar)[XB_TMO], 1u); break; } } } } while (0)
struct XcdBarrier { unsigned* bar; unsigned x; volatile LAS unsigned* st; unsigned G; bool wave0; };
__device__ __forceinline__ XcdBarrier xcd_barrier_post(unsigned* bar, volatile LAS unsigned* st, unsigned G) {
    XcdBarrier b; b.bar = bar; b.x = xb_xcc_id(); b.st = st; b.G = G; b.wave0 = (__builtin_amdgcn_readfirstlane(threadIdx.x >> 6) == 0);
    if (threadIdx.x == 0) (void)xb_add(&bar[XB_XCNT(b.x)], 1u);
    return b;
}
__device__ __forceinline__ void xcd_barrier_complete(unsigned* bar, unsigned x, unsigned G, unsigned& nloc, unsigned& nx) {
    unsigned sum, cnt, mine, sp = 0u;
    for (;;) {
        sum = 0u; cnt = 0u; mine = 0u;
#pragma unroll
        for (unsigned j = 0; j < 16; ++j) { const unsigned c = xb_ld(&bar[XB_XCNT(j)]); sum += c; cnt += (c > 0u) ? 1u : 0u; mine = (j == x) ? c : mine; }
        if (sum == G) break;
        __builtin_amdgcn_s_sleep(1);
        if ((++sp & 255u) == 0u) { if (xb_ld(&bar[XB_TMO])) break; if (sp > XB_SPIN_CAP) { atomicAdd(&bar[XB_TMO], 1u); break; } }
    }
    nloc = mine > 0u ? mine : 1u; nx = cnt > 0u ? cnt : 1u;
}
__device__ __forceinline__ void xcd_barrier(const XcdBarrier& b, const bool full = true) {
    asm volatile("s_waitcnt vmcnt(0)" ::: "memory");
    __syncthreads();
    if (b.wave0 && hw_lane() == 0) {
        unsigned* bar = b.bar;
        __builtin_amdgcn_s_waitcnt(0);
        unsigned nloc = b.st[0], nx = b.st[1];
        if (nloc == 0u) { xcd_barrier_complete(bar, b.x, b.G, nloc, nx); b.st[0] = nloc; b.st[1] = nx; }
        const unsigned old = xb_add(&bar[XB_XSUB(b.x)], 1u);
        const unsigned gen = old / nloc;
        if (old + 1u == (gen + 1u) * nloc) {
            if (full || nx > 1u) {
                __builtin_amdgcn_fence(__ATOMIC_RELEASE, "agent");
                asm volatile("s_waitcnt vmcnt(0)" ::: "memory");
            }
            if (nx > 1u) {
            const unsigned og = xb_add(&bar[XB_TOP], 1u);
            const unsigned tg = og / nx;
            if (og + 1u == (tg + 1u) * nx) xb_add(&bar[XB_TOPGEN], 1u);
            else XB_SPIN(xb_ld(&bar[XB_TOPGEN]) == tg, bar);
            }
            xb_add(&bar[XB_XGEN(b.x)], 1u);
            __builtin_amdgcn_fence(__ATOMIC_ACQUIRE, "agent");
            asm volatile("s_waitcnt vmcnt(0)" ::: "memory");
        } else {
            XB_SPIN(xb_ld(&bar[XB_XGEN(b.x)]) == gen, bar);
            __builtin_amdgcn_fence(__ATOMIC_ACQUIRE, "agent");
            asm volatile("s_waitcnt vmcnt(0)" ::: "memory");
        }
    }
    __syncthreads();
}


__global__ void __launch_bounds__(NWAVES * 64, 2) mk_fwd(Args args) {
    extern __shared__ __attribute__((aligned(16))) unsigned char lds[];
    Frame F;
    F.lds = (LAS unsigned char*)lds;
    F.tid = threadIdx.x; F.lane = F.tid & 63; F.wave = __builtin_amdgcn_readfirstlane(F.tid >> 6);
    F.G = gridDim.x; { const int bx = blockIdx.x; F.vcu = (F.G % 8 == 0) ? (bx % 8) * (F.G / 8) + bx / 8 : bx; }
    F.kp = (kargp_t)__builtin_amdgcn_kernarg_segment_ptr();
    if (threadIdx.x < 64) ((LAS unsigned*)(F.lds + MISC_OFF))[threadIdx.x] = 0u;
    __syncthreads();
    { const XcdBarrier g0 = xcd_barrier_post((unsigned*)F.wsb(), (volatile LAS unsigned*)(F.lds + MISC_OFF), gridDim.x); (void)g0;
      if (gridDim.x == 256) { const XcdBarrier b0 = xcd_barrier_post((unsigned*)F.wsb() + (1 + (blockIdx.x & 7)) * XCD_BAR_WORDS, (volatile LAS unsigned*)(F.lds + MISC_OFF + 16), 32u); (void)b0; } }
#define GBAR() (XcdBarrier{(unsigned*)F.wsb(), xb_xcc_id(), (volatile LAS unsigned*)(F.lds + MISC_OFF), gridDim.x, F.wave == 0})
#define BBAR() (gridDim.x == 256 ? XcdBarrier{(unsigned*)F.wsb() + (1 + (blockIdx.x & 7)) * XCD_BAR_WORDS, xb_xcc_id(), (volatile LAS unsigned*)(F.lds + MISC_OFF + 16), 32u, F.wave == 0} : GBAR())

#define IN_PH (F.fresh(), true)
#define SEAM() do { xcd_barrier(GBAR()); } while (0)
#define SEAMB() do { xcd_barrier(BBAR(), false); } while (0)
#define SEAMBF() do { xcd_barrier(BBAR(), true); } while (0)
    const int NOMOD = 1 << 30;

    if (IN_PH) p0_prologue(F);
    SEAM();
    for (int l = 0; l < DEPTH; ++l) {
        const int li = l >> 1;
        if (F.G == 256 && l > 0) {
            if (F.wave == 0 && hw_lane() == 0) { unsigned* wc_ = (unsigned*)F.wsb() + WCNT_WORD + 16 * l; XB_SPIN(xb_ld(wc_) < 2056u, (unsigned*)F.wsb());
                                                 __builtin_amdgcn_fence(__ATOMIC_ACQUIRE, "agent"); asm volatile("s_waitcnt vmcnt(0)" ::: "memory"); }
            __syncthreads();
        }
        if ((l & 1) == 0) {
            if (IN_PH) {
                pg8::Gemm g{F_XB, F_W + W_EVIN + li * SZ_EVIN, M, EV_IN, D, 256, 32, 64, NOMOD, 0, 0xFEDCBA5476983210ull};
                pg8::StaticOrder S; S.init(M, EV_IN, F.G, (int)blockIdx.x);

                pg8::EpiEven E{F_SS, F_ROPE, F.inf(I_EV_Q_GAIN) + li * 64, F.inf(I_EV_K_GAIN) + li * 64, F.inf(I_EV_LN_G) + li * 512, F.inf(I_EV_LN_B) + li * 512,
                               F_RA, F_RA + 8 * Mi, F_RA + 16 * Mi, F_RA + 24 * Mi, F_RA + 32 * Mi, F_KMP};
                pg8::gemm_phase<pg8::EpiEven, pg8::StaticOrder, true, true, true>(F.lds, g, S, E, F.wave);
            }
            if (IN_PH) {
                pg8::Gemm g{F_MEMB, F_W + W_XKV, 4 * MM, 2 * D, D, 256, 32, 64, MM / 256, (size_t)2 * Mi * 2, 0xFEDCBA9876543210ull};
                pg8::MemKVOrder S{F.G == 256 ? ((int)blockIdx.x >= 128 ? (int)blockIdx.x - 128 : 128) : (int)blockIdx.x, F.G == 256 ? 128 : F.G, l};
                pg8::EpiMemKV E{F_KXN, F_VX, F_SSM, F.inf(I_XA_K_GAIN), F.inf(I_XA_Q_GAIN), (LAS float*)(F.lds + RING_BYTES)};
                pg8::gemm_phase<pg8::EpiMemKV, pg8::MemKVOrder, true>(F.lds, g, S, E, F.wave);
            }
            SEAMB();
            if (IN_PH) { moba_mfma(F); __syncthreads(); gmlp_mfma(F, li); }
            SEAMB();
            if (IN_PH) {
                pg8::Gemm g{F_CAT, F_W + W_EVOUT + li * Mi, M, D, D, 256, 32, 64, NOMOD, 0, 0xFEDCBA9876543210ull};
                pg8::StaticOrder S; S.init(M, D, F.G, (int)blockIdx.x);
                if (l == 0) { pg8::EpiResid<true, false> E{F_X, nullptr, F_XB, F_SS}; pg8::gemm_phase<pg8::EpiResid<true, false>, pg8::StaticOrder, true>(F.lds, g, S, E, F.wave); }
                else { pg8::EpiResid<false, false> E{nullptr, nullptr, F_XB, F_SS}; pg8::gemm_phase<pg8::EpiResid<false, false>, pg8::StaticOrder, true>(F.lds, g, S, E, F.wave); }
            }
            SEAMB();
        } else {
            if (IN_PH) {
                pg8::Gemm g{F_XB, F_W + W_ODIN + li * SZ_ODIN, M, OD_IN, D, 256, 32, 64, NOMOD, 0, 0xFEDCBA9876543210ull};
                pg8::StaticOrder S; S.init(M, OD_IN, F.G, (int)blockIdx.x);
                pg8::EpiStore E{F_RA, OD_IN, F_SS, -1, 512, 0.08838834764831845f};
                pg8::gemm_phase<pg8::EpiStore, pg8::StaticOrder, true, true>(F.lds, g, S, E, F.wave, F_SS);
                gate_t16(F, l, li);
            }
            SEAMB();
            if (IN_PH) gla_g1(F, li);
            SEAMB();
            if (IN_PH) gla_g2(F, li);
            SEAMB();
            if (IN_PH) {
                pg8::Gemm g{F_CAT, F_W + W_ODOUT + li * Mi, M, D, D, 256, 32, 64, NOMOD, 0, 0xFEDCBA9876543210ull};
                pg8::StaticOrder S; S.init(M, D, F.G, (int)blockIdx.x);
                pg8::EpiResid<false, false> E{nullptr, nullptr, F_XB, F_SS};
                pg8::gemm_phase<pg8::EpiResid<false, false>, pg8::StaticOrder, true>(F.lds, g, S, E, F.wave);
            }
            SEAMB();
        }
        if (IN_PH) {
            pg8::Gemm g{F_XB, F_W + W_XQ + l * Mi, M, D, D, 256, 32, 64, NOMOD, 0, 0xFEDCBA9876543210ull};
            pg8::StaticOrder S; S.init(M, D, F.G, (int)blockIdx.x);
            pg8::EpiStoreQT E{F_RA, F_SS};
            pg8::gemm_phase<pg8::EpiStoreQT, pg8::StaticOrder, true, true>(F.lds, g, S, E, F.wave, F_SS);
            asm volatile("s_waitcnt vmcnt(0)" ::: "memory"); __syncthreads();
            if (F.wave == 0) { __builtin_amdgcn_fence(__ATOMIC_ACQUIRE, "agent"); asm volatile("s_waitcnt vmcnt(0)" ::: "memory"); }
            __syncthreads();
            xattn_mfma(F, l, S);
        }
        SEAMB();
        if (IN_PH) {
            pg8::Gemm g{F_CAT, F_W + W_XO + l * Mi, M, D, D, 256, 32, 64, NOMOD, 0, 0xFEDCBA9876543210ull};
            pg8::StaticOrder S; S.init(M, D, F.G, (int)blockIdx.x);
            pg8::EpiResid<false, false> E{nullptr, nullptr, F_XB, F_SS};
            pg8::gemm_phase<pg8::EpiResid<false, false>, pg8::StaticOrder, true>(F.lds, g, S, E, F.wave);
        }
        SEAMB();
        if (IN_PH) {
            pg8::Gemm g{F_XB, F_W + W_GU + l * SZ_GU, M, 2 * DFF, D, 128, DFF, 32, NOMOD, 0, 0xFEDCBA9876543210ull};
            pg8::StaticOrder S; S.init(M, 2 * DFF, F.G, (int)blockIdx.x);
            pg8::EpiSwiglu E{F_RA + 16 * Mi, DFF, F_SS};
            pg8::gemm_phase<pg8::EpiSwiglu, pg8::StaticOrder, true, true>(F.lds, g, S, E, F.wave, F_SS);
            if (F.G == 256 && l + 1 < DEPTH && (int)blockIdx.x >= 128) {
                __syncthreads();
                const int f0 = p0_layer_first(l + 1);
                p0_convert(F, f0 + ((int)blockIdx.x - 128) * NWAVES + F.wave, 128 * NWAVES, f0 + (((l + 1) & 1) ? 7296 : 7040));
            }
        }
        if (l + 1 < DEPTH) SEAMBF(); else SEAMB();
        if (F.G == 256 && l + 1 < DEPTH && blockIdx.x < 8 && F.wave == 0 && hw_lane() == 0) (void)xb_add((unsigned*)F.wsb() + WCNT_WORD + 16 * (l + 1), 1u);
        if (IN_PH) {
            pg8::Gemm g{F_RA + 16 * Mi, F_W + W_DN + l * SZ_DN, M, D, DFF, 256, 32, 64, NOMOD, 0, 0xFEDCBA9876543210ull};
            pg8::StaticOrder S; S.init(M, D, F.G, (int)blockIdx.x);
            if (l == DEPTH - 1) { pg8::EpiResid<false, true> E{nullptr, F_OUT, F_XB, F_SS}; pg8::gemm_phase<pg8::EpiResid<false, true>, pg8::StaticOrder, true>(F.lds, g, S, E, F.wave); }
            else { pg8::EpiResid<false, false> E{nullptr, nullptr, F_XB, F_SS}; pg8::gemm_phase<pg8::EpiResid<false, false>, pg8::StaticOrder, true>(F.lds, g, S, E, F.wave); }
        }
        if (l + 1 < DEPTH) {
            if (hw_lane() == 0) { unsigned* fp_ = (unsigned*)F.wsb() + WCNT_WORD + 16 * (l + 1); asm volatile("" : "+s"(fp_)); (void)xb_add(fp_, 1u); }
            SEAMB();
        }
    }
#undef IN_PH
#undef SEAM
#undef SEAMB
#undef SEAMBF
#undef GBAR
#undef BBAR
}

extern "C" void kernel_launch(void* const* d_in, const int* in_sizes, int n_in, void* d_out, int out_size, void* d_ws, size_t ws_size, hipStream_t stream) {
    static int grid = 0;
    if (grid == 0) {
        if (n_in != 28 || out_size != M * D || ws_size < WS_END) { fprintf(stderr, "kernel_launch: unexpected problem (n_in %d out %d ws %zu)\n", n_in, out_size, ws_size); grid = -1; return; }
        int dev = 0, cus = 0, per_cu = 0;
        hipGetDevice(&dev); hipDeviceGetAttribute(&cus, hipDeviceAttributeMultiprocessorCount, dev);
        if (hipFuncSetAttribute((const void*)mk_fwd, hipFuncAttributeMaxDynamicSharedMemorySize, LDS_BYTES) != hipSuccess) { fprintf(stderr, "kernel_launch: hipFuncSetAttribute failed\n"); grid = -1; return; }
        hipOccupancyMaxActiveBlocksPerMultiprocessor(&per_cu, (const void*)mk_fwd, NWAVES * 64, LDS_BYTES);
        (void)hipGetLastError();
        if (per_cu < 1) { fprintf(stderr, "kernel_launch: occupancy query says %d blocks per CU\n", per_cu); }
        grid = cus;
    }
    if (grid < 0) return;
    if (hipMemsetAsync(d_ws, 0, 262144, stream) != hipSuccess) { fprintf(stderr, "kernel_launch: hipMemsetAsync failed\n"); return; }
    Args a{};
    for (int i = 0; i < 28; ++i) a.in[i] = d_in[i];
    a.out = (float*)d_out; a.ws = (unsigned char*)d_ws;
    void* kargs[] = {&a};
    hipError_t e = hipLaunchCooperativeKernel((const void*)mk_fwd, dim3(grid), dim3(NWAVES * 64), kargs, LDS_BYTES, stream);
    if (e != hipSuccess) fprintf(stderr, "cooperative launch failed: %s (grid %d)\n", hipGetErrorString(e), grid);
}
```

```cpp
#include <hip/hip_runtime.h>
#include <cstdio>
#include <cstdint>

namespace pg8 {
#define PG8_LAS __attribute__((address_space(3)))
typedef unsigned short bf16_t;
typedef short bf16x8 __attribute__((ext_vector_type(8)));
typedef float f32x4 __attribute__((ext_vector_type(4)));
typedef float f32x2 __attribute__((ext_vector_type(2)));
typedef unsigned u32x4 __attribute__((ext_vector_type(4)));
constexpr int BM = 256, BK = 64, HALF = 128, HTB = HALF * BK * 2, STAGE_BYTES = 8 * HTB, NXCD = 8, WGM = 8;

__host__ __device__ __forceinline__ int lds_byte(int r, int c) { const int st = (r >> 4) * 2 + (c >> 5), rr = r & 15, cc = c & 31, ob = rr * 64 + cc * 2; return st * 1024 + (ob ^ (((ob >> 9) & 1) << 5)); }
__host__ __device__ __forceinline__ void stage_rc(int b, int& R, int& C) { const int st = b / 1024, sb = b % 1024, swz = sb ^ (((sb >> 9) & 1) << 5); R = (st >> 1) * 16 + swz / 64; C = (st & 1) * 32 + (swz % 64) / 2; }
__host__ __device__ __forceinline__ int perm32(int rho) { const int n = rho >> 4, i = rho & 15; return 8 * (i >> 2) + 4 * n + (i & 3); }

struct Unit { int pm, pn; };
struct Gemm { const bf16_t* A; const bf16_t* Bt; int M, N, K; int bTile, bHalf, bGrp; int aTileMod; size_t bBatchBytes; unsigned long long pnmap; };
__host__ __device__ __forceinline__ int pn_logical(unsigned long long map, int pn) { return pn < 16 ? (int)((map >> (4 * pn)) & 15ull) : pn; }

struct StaticOrder {
    int nM, nN, nwg, G, c;
    __host__ __device__ void init(int M, int N, int G_, int c_) { nM = M / BM; nN = N / BM; nwg = nM * nN; G = G_; c = c_; }
    __host__ __device__ bool next(int i, Unit& u) const {
        const long L = (long)i * G + c; if (L >= nwg) return false;
        int wgid = (int)L; { const int q = nwg / NXCD, r = nwg % NXCD, xcd = wgid % NXCD, off = wgid / NXCD; wgid = (xcd < r ? xcd * (q + 1) : r * (q + 1) + (xcd - r) * q) + off; }
        const int nig = WGM * nN, gid = wgid / nig, fm = gid * WGM, gsz = (nM - fm) < WGM ? (nM - fm) : WGM;
        u.pm = fm + ((wgid % nig) % gsz); u.pn = (wgid % nig) / gsz; return true;
    }
};

struct MemKVOrder {
    int first, step, lbase;
    __host__ __device__ bool next(int i, Unit& u) const { const int idx = first + i * step; if (idx >= 128) return false; const int j = idx >> 3; u.pm = (lbase + (j >> 3)) * 8 + (idx & 7); u.pn = j & 7; return true; }
};

typedef __bf16 bf16x2_t __attribute__((ext_vector_type(2)));
__device__ __forceinline__ unsigned cvt_pk_bf16(float lo, float hi) { const f32x2 v = {lo, hi}; const bf16x2_t b = __builtin_convertvector(v, bf16x2_t); return __builtin_bit_cast(unsigned, b); }
typedef _Float16 half2_t __attribute__((ext_vector_type(2)));
typedef _Float16 half8_t __attribute__((ext_vector_type(8)));
__device__ __forceinline__ unsigned cvt_pk_f16(float lo, float hi) { const f32x2 v = {lo, hi}; const half2_t h = __builtin_convertvector(v, half2_t); return __builtin_bit_cast(unsigned, h); }
__device__ __forceinline__ f32x2 unpk_f16(unsigned w) { const half2_t h = __builtin_bit_cast(half2_t, w); return __builtin_convertvector(h, f32x2); }
__device__ __forceinline__ f32x2 gelu_pk(f32x2 v) {
    const f32x2 av = __builtin_elementwise_abs(v), d = av * 0.2316418882f + 1.0f;
    f32x2 t; t.x = __builtin_amdgcn_rcpf(d.x); t.y = __builtin_amdgcn_rcpf(d.y);
    f32x2 q = t * 0.5307027145f + (-0.7265760135f); q = q * t + 0.7107068705f; q = q * t + (-0.142248368f); q = q * t + 0.127414796f; q = q * t;
    const f32x2 s = (v * v) * (-0.72134752044f);
    f32x2 e; e.x = __builtin_amdgcn_exp2f(s.x); e.y = __builtin_amdgcn_exp2f(s.y);
    const f32x2 m = v * (q * e), r = v - m;
    f32x2 o; o.x = v.x < 0.f ? m.x : r.x; o.y = v.y < 0.f ? m.y : r.y; return o;
}
__device__ __forceinline__ float row_rstd(const float* SS, int row) {
    const f32x4* p = (const f32x4*)(SS + (unsigned)row * 16u); const f32x4 a = p[0], b = p[1], c = p[2], d = p[3];
    const float s = ((a[0] + a[1]) + (a[2] + a[3])) + ((b[0] + b[1]) + (b[2] + b[3])) + ((c[0] + c[1]) + (c[2] + c[3])) + ((d[0] + d[1]) + (d[2] + d[3]));
    return __builtin_amdgcn_rsqf(s * (1.0f / 1024.0f) + 1e-6f);
}
constexpr int EV_ROPE_TAB = 131072, EV_GAIN_TAB = 131072 + 8192 + 2048;
constexpr int RSTD_TAB = 131072 + 8192;
__device__ __forceinline__ void rstd8(float (&rs)[2][4], PG8_LAS unsigned char* lds, const float* SS, int upm, int wr, int fr) {
    const PG8_LAS float* tab = (const PG8_LAS float*)(lds + RSTD_TAB);
    if (*(const PG8_LAS int*)(lds + RSTD_TAB + 1024) == upm) {
#pragma unroll
        for (int ai = 0; ai < 2; ++ai)
#pragma unroll
            for (int m = 0; m < 4; ++m) rs[ai][m] = tab[ai * HALF + wr * 64 + m * 16 + fr];
    } else {
#pragma unroll
        for (int ai = 0; ai < 2; ++ai)
#pragma unroll
            for (int m = 0; m < 4; ++m) { rs[ai][m] = row_rstd(SS, upm * BM + ai * HALF + wr * 64 + m * 16 + fr); if (m & 1) asm volatile("" ::: "memory"); }
    }
}
__device__ __forceinline__ u32x4 pack8(const float* v) { u32x4 w; w.x = cvt_pk_bf16(v[0], v[1]); w.y = cvt_pk_bf16(v[2], v[3]); w.z = cvt_pk_bf16(v[4], v[5]); w.w = cvt_pk_bf16(v[6], v[7]); return w; }


struct EpiStore {
    bf16_t* O; int ldc; const float* SS; int ssMask; int scols; float cscale;
    __device__ __forceinline__ void operator()(const f32x4 (&acc)[2][2][4][2], const Unit& u, int wr, int wc, int fr, int fq, PG8_LAS unsigned char* lds) const {
        const int c0 = u.pn * BM + wc * 64 + 8 * fq;
        float rsv[2][4]; rstd8(rsv, lds, SS, u.pm, wr, fr);
#pragma unroll
        for (int ai = 0; ai < 2; ++ai)
#pragma unroll
            for (int m = 0; m < 4; ++m) {
                const int row = u.pm * BM + ai * HALF + wr * 64 + m * 16 + fr;
                const float rs = rsv[ai][m];
#pragma unroll
                for (int bj = 0; bj < 2; ++bj) {
                    const int col = c0 + 32 * bj; const float sc = rs * (col < scols ? cscale : 1.0f);
                    float v[8];
#pragma unroll
                    for (int n = 0; n < 2; ++n)
#pragma unroll
                        for (int e = 0; e < 4; ++e) v[4 * n + e] = acc[ai][bj][m][n][e] * sc;
                    *(u32x4*)(O + ((unsigned)row * (unsigned)ldc + (unsigned)col)) = pack8(v);
                }
            }
    }
};
struct EpiMemKV {
    bf16_t* KXN; bf16_t* VX; const float* SSM; const float* kg; const float* qg; PG8_LAS float* P;
    __device__ __forceinline__ void operator()(const f32x4 (&acc)[2][2][4][2], const Unit& u, int wr, int wc, int fr, int fq, PG8_LAS unsigned char* lds) const {
        asm volatile("" : "+v"(fr), "+v"(fq));
        const int lyr = u.pm >> 3; const bool isk = u.pn < 4; const int head = u.pn & 3;
        float rsv[2][4], gk[2][8];
        if (*(const PG8_LAS int*)(lds + RSTD_TAB + 1024) != 0x1000 + u.pm) {
            __syncthreads();
            const int tid = (wr * 4 + wc) * 64 + fq * 16 + fr;
            if (tid < 256) ((PG8_LAS float*)(lds + RSTD_TAB))[tid] = row_rstd(SSM, (u.pm * BM + tid) & 2047);
            if (tid == 0) *(PG8_LAS int*)(lds + RSTD_TAB + 1024) = 0x1000 + u.pm;
            __syncthreads();
        }
        { const PG8_LAS float* tab = (const PG8_LAS float*)(lds + RSTD_TAB);
#pragma unroll
          for (int ai = 0; ai < 2; ++ai)
#pragma unroll
            for (int m = 0; m < 4; ++m) rsv[ai][m] = tab[ai * HALF + wr * 64 + m * 16 + fr]; }
#pragma unroll
        for (int bj = 0; bj < 2; ++bj) {
            const int col = lyr * 256 + wc * 64 + 32 * bj + 8 * fq;
            f32x4 k0 = {1.f, 1.f, 1.f, 1.f}, k1 = k0, q0 = k0, q1 = k0;
            if (isk) { k0 = *(const f32x4*)(kg + col); k1 = *(const f32x4*)(kg + col + 4); q0 = *(const f32x4*)(qg + col); q1 = *(const f32x4*)(qg + col + 4); }
#pragma unroll
            for (int e = 0; e < 4; ++e) { gk[bj][e] = k0[e] * q0[e]; gk[bj][4 + e] = k1[e] * q1[e]; }
        }
        if (isk) {
#pragma unroll
            for (int ai = 0; ai < 2; ++ai)
#pragma unroll
                for (int m = 0; m < 4; ++m) {
                    const int rt = ai * HALF + wr * 64 + m * 16 + fr; const float rs = rsv[ai][m]; float ss = 0.f;
#pragma unroll
                    for (int bj = 0; bj < 2; ++bj)
#pragma unroll
                        for (int n = 0; n < 2; ++n)
#pragma unroll
                            for (int e = 0; e < 4; ++e) { const float v = acc[ai][bj][m][n][e] * rs; ss += v * v; }
                    ss += __shfl_xor(ss, 16); ss += __shfl_xor(ss, 32);
                    if (fq == 0) P[rt * 4 + wc] = ss;
                }
            asm volatile("s_waitcnt lgkmcnt(0)" ::: "memory"); __builtin_amdgcn_s_barrier(); asm volatile("" ::: "memory");
        }
        bf16_t* dst = isk ? KXN : VX;
#pragma unroll
        for (int ai = 0; ai < 2; ++ai)
#pragma unroll
            for (int m = 0; m < 4; ++m) {
                const int rt = ai * HALF + wr * 64 + m * 16 + fr;
                float sc = rsv[ai][m];
                if (isk) { const f32x4 p4 = *(const PG8_LAS f32x4*)(P + rt * 4); sc *= __builtin_amdgcn_rsqf(((p4[0] + p4[1]) + (p4[2] + p4[3])) * (1.0f / 256.0f) + 1e-6f); }
#pragma unroll
                for (int bj = 0; bj < 2; ++bj) {
                    const int col = wc * 64 + 32 * bj + 8 * fq;
                    float v[8];
#pragma unroll
                    for (int n = 0; n < 2; ++n)
#pragma unroll
                        for (int e = 0; e < 4; ++e) v[4 * n + e] = acc[ai][bj][m][n][e] * sc * gk[bj][4 * n + e];
                    const int ch = col >> 3;
                    const unsigned off = (unsigned)((u.pm * 4 + head) * 65536 + rt * 256 + ((ch ^ (isk ? (rt & 15) : ((rt & 3) << 2))) << 3));
                    *(u32x4*)(dst + off) = pack8(v);
                }
                asm volatile("" ::: "memory");
            }
        if (isk) { asm volatile("s_waitcnt lgkmcnt(0)" ::: "memory"); __builtin_amdgcn_s_barrier(); asm volatile("" ::: "memory"); }
    }
};
struct EpiStoreQT {
    bf16_t* O; const float* SS;
    __device__ __forceinline__ void operator()(const f32x4 (&acc)[2][2][4][2], const Unit& u, int wr, int wc, int fr, int fq, PG8_LAS unsigned char* lds) const {
        float rsv[2][4]; rstd8(rsv, lds, SS, u.pm, wr, fr);
#pragma unroll
        for (int ai = 0; ai < 2; ++ai)
#pragma unroll
            for (int m = 0; m < 4; ++m) {
                const int rt = ai * HALF + wr * 64 + m * 16 + fr, row = u.pm * BM + rt; (void)row;
                const float rs = rsv[ai][m];
#pragma unroll
                for (int bj = 0; bj < 2; ++bj) {
                    const int sidx = 4 * wc + 2 * bj + (fq >> 1);
                    const unsigned off = (unsigned)(((((u.pm * 4 + u.pn) * 8 + (rt >> 5)) * 16 + sidx) * 32 + (rt & 31)) * 16 + 8 * (fq & 1));
                    float v[8];
#pragma unroll
                    for (int n = 0; n < 2; ++n)
#pragma unroll
                        for (int e = 0; e < 4; ++e) v[4 * n + e] = acc[ai][bj][m][n][e] * rs;
                    *(u32x4*)(O + off) = pack8(v);
                }
            }
    }
};
template <bool BASE32, bool OUT32> struct EpiResid {
    const float* base32; float* out32; bf16_t* XH; float* SS;
    __device__ __forceinline__ void operator()(const f32x4 (&acc)[2][2][4][2], const Unit& u, int wr, int wc, int fr, int fq, PG8_LAS unsigned char* lds) const {
        const int c0 = u.pn * BM + wc * 64 + 8 * fq;
#pragma unroll
        for (int ai = 0; ai < 2; ++ai)
#pragma unroll
            for (int m = 0; m < 4; ++m) {
                const int row = u.pm * BM + ai * HALF + wr * 64 + m * 16 + fr; float ss = 0.f;
#pragma unroll
                for (int bj = 0; bj < 2; ++bj) {
                    const unsigned off = (unsigned)row * 1024u + (unsigned)c0 + 32u * bj;
                    f32x4 o0, o1;
                    if (BASE32) { o0 = *(const f32x4*)(base32 + off); o1 = *(const f32x4*)(base32 + off + 4); }
                    else { const u32x4 bw = *(const u32x4*)(XH + off); const f32x2 a = unpk_f16(bw.x), b = unpk_f16(bw.y), c = unpk_f16(bw.z), d = unpk_f16(bw.w);
                           o0 = (f32x4){a.x, a.y, b.x, b.y}; o1 = (f32x4){c.x, c.y, d.x, d.y}; }
                    o0 += acc[ai][bj][m][0]; o1 += acc[ai][bj][m][1];
                    if (OUT32) { *(f32x4*)(out32 + off) = o0; *(f32x4*)(out32 + off + 4) = o1; }
                    else {
                    u32x4 w; w.x = cvt_pk_f16(o0[0], o0[1]); w.y = cvt_pk_f16(o0[2], o0[3]); w.z = cvt_pk_f16(o1[0], o1[1]); w.w = cvt_pk_f16(o1[2], o1[3]);
                    *(u32x4*)(XH + off) = w;
                    ss += (o0[0] * o0[0] + o0[1] * o0[1]) + (o0[2] * o0[2] + o0[3] * o0[3]) + (o1[0] * o1[0] + o1[1] * o1[1]) + (o1[2] * o1[2] + o1[3] * o1[3]);
                    }
                }
                if (!OUT32) {
                ss += __shfl_xor(ss, 16); ss += __shfl_xor(ss, 32);
                if (fq == 0) SS[(unsigned)row * 16u + (unsigned)(u.pn * 4 + wc)] = ss;
                }
            }
    }
};
struct EpiSwiglu {
    bf16_t* HID; int ldc; const float* SS;
    __device__ __forceinline__ void operator()(const f32x4 (&acc)[2][2][4][2], const Unit& u, int wr, int wc, int fr, int fq, PG8_LAS unsigned char* lds) const {
        const int col = u.pn * 128 + wc * 32 + 8 * fq;
        float rsv[2][4]; rstd8(rsv, lds, SS, u.pm, wr, fr);
#pragma unroll
        for (int ai = 0; ai < 2; ++ai)
#pragma unroll
            for (int m = 0; m < 4; ++m) {
                const int row = u.pm * BM + ai * HALF + wr * 64 + m * 16 + fr; const float rs = rsv[ai][m];
                float v[8];
#pragma unroll
                for (int n = 0; n < 2; ++n)
#pragma unroll
                    for (int e = 0; e < 4; ++e) { const float g = acc[ai][0][m][n][e] * rs, uu = acc[ai][1][m][n][e] * rs; v[4 * n + e] = g * __builtin_amdgcn_rcpf(1.0f + __expf(-g)) * uu; }
                *(u32x4*)(HID + ((unsigned)row * (unsigned)ldc + (unsigned)col)) = pack8(v);
            }
    }
};
struct EpiEven {
    const float* SS; const float* rope;
    const float *q_gain, *k_gain, *ln_g, *ln_b;
    bf16_t *Q, *K, *V, *U, *VN; float* KMP;
    template <int TYPE> __device__ __forceinline__ void tile(const f32x4 (&acc)[2][2][4][2], const float (&rsv)[2][4], const Unit& u, int wr, int wc, int fr, int fq, PG8_LAS unsigned char* lds) const {
        asm volatile("; even tile type %0" :: "n"(TYPE) : "memory");
        const int head = (u.pn & 1) * 4 + wc, cb = head * 64 + 8 * fq;
        bf16_t* dst = TYPE == 0 ? Q : TYPE == 1 ? K : TYPE == 2 ? V : TYPE == 3 ? U : VN;
        const PG8_LAS float* gt = (const PG8_LAS float*)(lds + EV_GAIN_TAB);
        float gn[2][8], bb[2][8], ks[2][8];
#pragma unroll
        for (int bj = 0; bj < 2; ++bj)
#pragma unroll
            for (int e = 0; e < 8; ++e) {
                gn[bj][e] = 1.f; bb[bj][e] = 0.f; ks[bj][e] = 0.f;
                if (TYPE == 0) gn[bj][e] = gt[32 * bj + 8 * fq + e];
                if (TYPE == 1) gn[bj][e] = gt[64 + 32 * bj + 8 * fq + e];
                if (TYPE == 4) { gn[bj][e] = gt[128 + cb + 32 * bj + e]; bb[bj][e] = gt[640 + cb + 32 * bj + e]; }
            }
#pragma unroll
        for (int ai = 0; ai < 2; ++ai)
#pragma unroll
            for (int m = 0; m < 4; ++m) {
                const int row = u.pm * BM + ai * HALF + wr * 64 + m * 16 + fr; const float rs = rsv[ai][m];
                float v[2][8];
#pragma unroll
                for (int bj = 0; bj < 2; ++bj)
#pragma unroll
                    for (int n = 0; n < 2; ++n)
#pragma unroll
                        for (int e = 0; e < 4; ++e) v[bj][4 * n + e] = acc[ai][bj][m][n][e] * rs;
                if (TYPE == 0 || TYPE == 1) {
                    float ss = 0.f;
#pragma unroll
                    for (int bj = 0; bj < 2; ++bj)
#pragma unroll
                        for (int e = 0; e < 8; ++e) ss += v[bj][e] * v[bj][e];
                    ss += __shfl_xor(ss, 16); ss += __shfl_xor(ss, 32);
                    const float rn = __builtin_amdgcn_rsqf(ss * (1.0f / 64.0f) + 1e-6f);
#pragma unroll
                    for (int bj = 0; bj < 2; ++bj)
#pragma unroll
                        for (int e = 0; e < 8; ++e) v[bj][e] = v[bj][e] * rn * gn[bj][e];
                    float pr[8];
#pragma unroll
                    for (int e = 0; e < 8; ++e) pr[e] = __shfl_xor(v[0][e], 16);
                    if (fq < 2) {
                        const PG8_LAS unsigned char* rp = lds + EV_ROPE_TAB + (ai * HALF + wr * 64 + m * 16 + fr) * 32;
                        const u32x4 cw = *(const PG8_LAS u32x4*)rp, sw = *(const PG8_LAS u32x4*)(rp + 16);
                        const f32x2 ca = unpk_f16(cw.x), cb_ = unpk_f16(cw.y), cc = unpk_f16(cw.z), cd = unpk_f16(cw.w), sa = unpk_f16(sw.x), sb = unpk_f16(sw.y), sc = unpk_f16(sw.z), sd = unpk_f16(sw.w);
                        const f32x4 c0 = {ca.x, ca.y, cb_.x, cb_.y}, c1 = {cc.x, cc.y, cd.x, cd.y}, s0 = {sa.x, sa.y, sb.x, sb.y}, s1 = {sc.x, sc.y, sd.x, sd.y};
                        const float sg = fq == 0 ? -1.f : 1.f;
#pragma unroll
                        for (int e = 0; e < 4; ++e) { v[0][e] = v[0][e] * c0[e] + sg * pr[e] * s0[e]; v[0][4 + e] = v[0][4 + e] * c1[e] + sg * pr[4 + e] * s1[e]; }
                    }
                    if (TYPE == 1) {
#pragma unroll
                        for (int bj = 0; bj < 2; ++bj)
#pragma unroll
                            for (int e = 0; e < 8; ++e) { ks[bj][e] += v[bj][e]; asm volatile("" : "+v"(ks[bj][e])); }
                    }
                }
                if (TYPE == 3 || TYPE == 4) {
#pragma unroll
                    for (int bj = 0; bj < 2; ++bj)
#pragma unroll
                        for (int e = 0; e < 8; e += 2) { const f32x2 g = gelu_pk((f32x2){v[bj][e], v[bj][e + 1]}); v[bj][e] = g.x; v[bj][e + 1] = g.y; }
                }
                if (TYPE == 4) {
                    float s = 0.f;
#pragma unroll
                    for (int bj = 0; bj < 2; ++bj)
#pragma unroll
                        for (int e = 0; e < 8; ++e) s += v[bj][e];
                    s += __shfl_xor(s, 16); s += __shfl_xor(s, 32);
                    const float mu = s * (1.0f / 64.0f); float q = 0.f;
#pragma unroll
                    for (int bj = 0; bj < 2; ++bj)
#pragma unroll
                        for (int e = 0; e < 8; ++e) { v[bj][e] -= mu; q += v[bj][e] * v[bj][e]; }
                    q += __shfl_xor(q, 16); q += __shfl_xor(q, 32);
                    const float rn = __builtin_amdgcn_rsqf(q * (1.0f / 64.0f) + 1e-6f);
#pragma unroll
                    for (int bj = 0; bj < 2; ++bj)
#pragma unroll
                        for (int e = 0; e < 8; ++e) v[bj][e] = v[bj][e] * rn * gn[bj][e] + bb[bj][e];
                }
#pragma unroll
                for (int bj = 0; bj < 2; ++bj) *(u32x4*)(dst + ((unsigned)row * 512u + (unsigned)cb + 32u * bj)) = pack8(v[bj]);
                asm volatile("" ::: "memory");
            }
        if (TYPE == 1) {
#pragma unroll
            for (int bj = 0; bj < 2; ++bj)
#pragma unroll
                for (int e = 0; e < 8; ++e) { float s = ks[bj][e]; s += __shfl_xor(s, 1); s += __shfl_xor(s, 2); s += __shfl_xor(s, 4); s += __shfl_xor(s, 8); ks[bj][e] = s; }
            if (fr == 0) {
                float* kp = KMP + (unsigned)((u.pm * 2 + wr) * 512 + cb);
#pragma unroll
                for (int bj = 0; bj < 2; ++bj)
#pragma unroll
                    for (int e = 0; e < 8; ++e) kp[32 * bj + e] = ks[bj][e];
            }
        }
        asm volatile("; end even tile type %0" :: "n"(TYPE) : "memory");
    }
    __device__ __forceinline__ void tables(PG8_LAS unsigned char* lds, int tid, int pm) const {
        const float *ss_ = SS, *rope_ = rope, *qg_ = q_gain, *kg_ = k_gain, *lg_ = ln_g, *lb_ = ln_b; int pmv = pm;
        asm volatile("" : "+s"(ss_), "+s"(rope_), "+s"(qg_), "+s"(kg_), "+s"(lg_), "+s"(lb_), "+s"(pmv));
        if (tid < 256) ((PG8_LAS float*)(lds + RSTD_TAB))[tid] = row_rstd(ss_, pmv * BM + tid);
        { const int row = tid >> 1, part = tid & 1; const float* rp = rope_ + (unsigned)(pmv * BM + row) * 16u + 8 * part;
          const f32x4 a = *(const f32x4*)rp, b = *(const f32x4*)(rp + 4);
          u32x4 w; w.x = cvt_pk_f16(a[0], a[1]); w.y = cvt_pk_f16(a[2], a[3]); w.z = cvt_pk_f16(b[0], b[1]); w.w = cvt_pk_f16(b[2], b[3]);
          *(PG8_LAS u32x4*)(lds + EV_ROPE_TAB + row * 32 + part * 16) = w; }
        { PG8_LAS float* gt = (PG8_LAS float*)(lds + EV_GAIN_TAB);
          if (tid < 64) gt[tid] = qg_[tid]; else if (tid < 128) gt[tid] = kg_[tid - 64];
          gt[128 + tid] = lg_[tid]; gt[640 + tid] = lb_[tid]; }
        if (tid == 0) *(PG8_LAS int*)(lds + RSTD_TAB + 1024) = pmv;
    }
    __device__ __forceinline__ void prefill(PG8_LAS unsigned char* lds, int tid, int pm) const { tables(lds, tid, pm); asm volatile("s_waitcnt lgkmcnt(0)" ::: "memory"); }
    __device__ __forceinline__ void operator()(const f32x4 (&acc)[2][2][4][2], const Unit& u, int wr, int wc, int fr, int fq, PG8_LAS unsigned char* lds) const {
        asm volatile("" : "+v"(fr), "+v"(fq));
        const int type = pn_logical(0xFEDCBA5476983210ull, u.pn) >> 1;
        if (*(const PG8_LAS int*)(lds + RSTD_TAB + 1024) != u.pm) {
            __syncthreads();
            tables(lds, (wr * 4 + wc) * 64 + fq * 16 + fr, u.pm);
            __syncthreads();
        }
        float rsv[2][4];
        { const PG8_LAS float* tab = (const PG8_LAS float*)(lds + RSTD_TAB);
#pragma unroll
          for (int ai = 0; ai < 2; ++ai)
#pragma unroll
            for (int m = 0; m < 4; ++m) rsv[ai][m] = tab[ai * HALF + wr * 64 + m * 16 + fr]; }
        if (type == 0) tile<0>(acc, rsv, u, wr, wc, fr, fq, lds);
        else if (type == 1) tile<1>(acc, rsv, u, wr, wc, fr, fq, lds);
        else if (type == 2) tile<2>(acc, rsv, u, wr, wc, fr, fq, lds);
        else if (type == 3) tile<3>(acc, rsv, u, wr, wc, fr, fq, lds);
        else tile<4>(acc, rsv, u, wr, wc, fr, fq, lds);
    }
};

template <class Epi, class Sched, bool ALIGN_EPI, bool F16 = false, bool PREFILL = false>
__device__ __forceinline__ void gemm_phase(PG8_LAS unsigned char* lds, const Gemm g, const Sched& S, const Epi& E, int wid, const float* rstd_SS = nullptr) {
    asm volatile("" : "+s"(wid));
    int lane; asm volatile("v_mbcnt_lo_u32_b32 %0, -1, 0\n\tv_mbcnt_hi_u32_b32 %0, -1, %0" : "=v"(lane));
    const int tid = wid * 64 + lane, wr = wid >> 2, wc = wid & 3, fr = lane & 15, fq = lane >> 4;
    const int K = g.K, nt = K / BK;
    unsigned voffA[2], voffB[2];
#pragma unroll
    for (int i = 0; i < 2; ++i) { int R, C; stage_rc(tid * 16 + i * 8192, R, C); const int Rb = g.bGrp * (R >> 5) + perm32(R & 31);
        voffA[i] = (unsigned)(R * K + C) * 2u; voffB[i] = (unsigned)(Rb * K + C) * 2u; }
    const size_t kstep = (size_t)(BK * 2);
    const size_t hstepA = (size_t)HALF * K * 2, tstepA = 2 * hstepA;
    const size_t hstepB = (size_t)g.bHalf * K * 2, tstepB = (size_t)g.bTile * K * 2;
    const unsigned ldsw = (unsigned)wid * 1024u;
    const int aoff = lds_byte(wr * 64 + fr, fq * 8), boff = lds_byte(wc * 32 + fr, fq * 8);
#define PG8_SA(b, h) (((b) * 2 + (h)) * HTB)
#define PG8_SB(b, h) ((4 + (b) * 2 + (h)) * HTB)
#define PG8_STAGE(bufoff, gbase, voff) do { _Pragma("unroll") for (int _i = 0; _i < 2; ++_i) \
        __builtin_amdgcn_global_load_lds((const unsigned*)((const char*)(gbase) + (voff)[_i]), (PG8_LAS unsigned*)(lds + (bufoff) + ldsw + _i * 8192), 16, 0, 0); } while (0)
#define PG8_LDA(dst, b, h) do { _Pragma("unroll") for (int m = 0; m < 4; ++m) _Pragma("unroll") for (int k = 0; k < 2; ++k) dst[m][k] = *(const PG8_LAS bf16x8*)(lds + PG8_SA(b, h) + aoff + m * 2048 + k * 1024); } while (0)
#define PG8_LDB(dst, b, h) do { _Pragma("unroll") for (int n = 0; n < 2; ++n) _Pragma("unroll") for (int k = 0; k < 2; ++k) dst[n][k] = *(const PG8_LAS bf16x8*)(lds + PG8_SB(b, h) + boff + n * 2048 + k * 1024); } while (0)
#define PG8_MMA(ai, bj, At, Bt) do { __builtin_amdgcn_s_setprio(1); _Pragma("unroll") for (int m = 0; m < 4; ++m) _Pragma("unroll") for (int n = 0; n < 2; ++n) _Pragma("unroll") for (int k = 0; k < 2; ++k) \
        acc[ai][bj][m][n] = F16 ? __builtin_amdgcn_mfma_f32_16x16x32_f16(__builtin_bit_cast(half8_t, Bt[n][k]), __builtin_bit_cast(half8_t, At[m][k]), acc[ai][bj][m][n], 0, 0, 0) \
                                : __builtin_amdgcn_mfma_f32_16x16x32_bf16(Bt[n][k], At[m][k], acc[ai][bj][m][n], 0, 0, 0); __builtin_amdgcn_s_setprio(0); } while (0)
#define PG8_WAIT_V(n) asm volatile("s_waitcnt vmcnt(" #n ")" ::: "memory")
#define PG8_WAIT_L(n) asm volatile("s_waitcnt lgkmcnt(" #n ")" ::: "memory")
#define PG8_BAR __builtin_amdgcn_s_barrier()
#define PG8_SCHED __builtin_amdgcn_sched_barrier(0)
#define PG8_PA(u) ((const char*)g.A + (size_t)((u).pm % g.aTileMod) * tstepA)
#define PG8_PB(u) ((const char*)g.Bt + (size_t)pn_logical(g.pnmap, (u).pn) * tstepB + (size_t)((u).pm / g.aTileMod) * g.bBatchBytes)
    Unit cur, nxt; int ui = 0;
    if (!S.next(0, cur)) return;
    f32x4 acc[2][2][4][2];
#pragma unroll
    for (int a = 0; a < 2; ++a)
#pragma unroll
        for (int b = 0; b < 2; ++b)
#pragma unroll
            for (int m = 0; m < 4; ++m)
#pragma unroll
                for (int n = 0; n < 2; ++n) acc[a][b][m][n] = (f32x4){0.f, 0.f, 0.f, 0.f};
    bf16x8 At[4][2], B0[2][2], B1[2][2];
    const char* cA = PG8_PA(cur); const char* cB = PG8_PB(cur);
    PG8_STAGE(PG8_SB(0, 0), cB, voffB); PG8_STAGE(PG8_SB(0, 1), cB + hstepB, voffB); PG8_STAGE(PG8_SA(0, 0), cA, voffA); PG8_STAGE(PG8_SA(0, 1), cA + hstepA, voffA);
    if constexpr (PREFILL) E.prefill(lds, tid, cur.pm);
    if (rstd_SS) {
        const float* ssp = rstd_SS; asm volatile("" : "+s"(ssp));
        if (tid < 256) ((PG8_LAS float*)(lds + RSTD_TAB))[tid] = row_rstd(ssp, cur.pm * BM + tid);
        int pmv = cur.pm; asm volatile("" : "+s"(pmv));
        if (tid == 0) *(PG8_LAS int*)(lds + RSTD_TAB + 1024) = pmv;
        PG8_WAIT_L(0);
    }
    if (wr == 1) PG8_BAR;
    PG8_WAIT_V(2); PG8_BAR;
    PG8_STAGE(PG8_SB(1, 0), cB + kstep, voffB); PG8_STAGE(PG8_SA(1, 0), cA + kstep, voffA); PG8_STAGE(PG8_SB(1, 1), cB + hstepB + kstep, voffB);
    PG8_WAIT_V(6); PG8_BAR;
    for (;;) {
        const bool has_next = S.next(ui + 1, nxt);
        const char* nA = has_next ? PG8_PA(nxt) : cA; const char* nB = has_next ? PG8_PB(nxt) : cB;
        for (int t = 0; t < nt; t += 2) {
            const bool last = (t == nt - 2);
            const char* a1 = cA + (size_t)(t + 1) * kstep;
            const char* a2 = last ? nA : cA + (size_t)(t + 2) * kstep; const char* b2 = last ? nB : cB + (size_t)(t + 2) * kstep;
            const char* a3 = a2 + kstep; const char* b3 = b2 + kstep;
            PG8_LDB(B0, 0, 0); PG8_LDB(B1, 0, 1); PG8_SCHED; PG8_LDA(At, 0, 0); PG8_STAGE(PG8_SA(1, 1), a1 + hstepA, voffA);
            PG8_WAIT_V(8); PG8_WAIT_L(0); PG8_BAR; PG8_MMA(0, 0, At, B0); PG8_MMA(0, 1, At, B1); PG8_BAR; PG8_SCHED;
            const bool drain = last && !has_next;
            PG8_LDA(At, 0, 1);
            if (!drain) { PG8_STAGE(PG8_SB(0, 0), b2, voffB); PG8_STAGE(PG8_SB(0, 1), b2 + hstepB, voffB); PG8_STAGE(PG8_SA(0, 0), a2, voffA); PG8_WAIT_V(8); } else { PG8_WAIT_V(2); }
            PG8_WAIT_L(0); PG8_BAR; PG8_MMA(1, 0, At, B0); PG8_MMA(1, 1, At, B1); PG8_BAR; PG8_SCHED;
            PG8_LDB(B0, 1, 0); PG8_LDB(B1, 1, 1); PG8_SCHED; PG8_LDA(At, 1, 0);
            if (!drain) { PG8_STAGE(PG8_SA(0, 1), a2 + hstepA, voffA); PG8_WAIT_V(8); } else { PG8_WAIT_V(0); }
            PG8_WAIT_L(0); PG8_BAR; PG8_MMA(0, 0, At, B0); PG8_MMA(0, 1, At, B1); PG8_BAR; PG8_SCHED;
            PG8_LDA(At, 1, 1);
            if (!drain) { PG8_STAGE(PG8_SB(1, 0), b3, voffB); PG8_STAGE(PG8_SB(1, 1), b3 + hstepB, voffB); PG8_STAGE(PG8_SA(1, 0), a3, voffA); PG8_WAIT_V(8); }
            PG8_WAIT_L(0); PG8_BAR; PG8_MMA(1, 0, At, B0); PG8_MMA(1, 1, At, B1); PG8_BAR; PG8_SCHED;
        }
        if constexpr (ALIGN_EPI) { if (wr == 0) PG8_BAR; }
        E(acc, cur, wr, wc, fr, fq, lds);
        if (!has_next) break;
#pragma unroll
        for (int a = 0; a < 2; ++a)
#pragma unroll
            for (int b = 0; b < 2; ++b)
#pragma unroll
                for (int m = 0; m < 4; ++m)
#pragma unroll
                    for (int n = 0; n < 2; ++n) acc[a][b][m][n] = (f32x4){0.f, 0.f, 0.f, 0.f};
        cur = nxt; cA = nA; cB = nB; ++ui;
        if constexpr (ALIGN_EPI) { if (wr == 1) PG8_BAR; }
    }
    PG8_WAIT_V(0);
    if constexpr (!ALIGN_EPI) { if (wr == 0) PG8_BAR; }
    PG8_BAR;
#undef PG8_SA
#undef PG8_SB
#undef PG8_STAGE
#undef PG8_LDA
#undef PG8_LDB
#undef PG8_MMA
#undef PG8_WAIT_V
#undef PG8_WAIT_L
#undef PG8_BAR
#undef PG8_SCHED
#undef PG8_PA
#undef PG8_PB
}
}

constexpr int NWAVES = 8;
constexpr int BATCH = 8, SEQ = 2048, D = 1024, DEPTH = 4, M = BATCH * SEQ, NMEM = 256, MM = BATCH * NMEM;
constexpr int EV_IN = 2560, OD_IN = 3072, DFF = 2816;
constexpr float EPSF = 1e-6f;

constexpr size_t MiB = (size_t)1 << 20;
constexpr size_t WS_ROPE = 1 * MiB, WS_SS = 2 * MiB, WS_T16 = 3 * MiB, WS_KMP = 4 * MiB, WS_SSM = 5 * MiB, WS_WSB = 6 * MiB, WS_W1G = 7 * MiB;
constexpr size_t WS_W = 8 * MiB;
constexpr size_t WS_XB = 136 * MiB, WS_CAT = 168 * MiB, WS_KXN = 200 * MiB, WS_VX = 216 * MiB, WS_RA = 232 * MiB, WS_END = 352 * MiB;
constexpr size_t Mi = (size_t)1 << 20;
constexpr size_t W_EVIN = 0, W_EVOUT = 5 * Mi, W_ODIN = 7 * Mi, W_ODOUT = 13 * Mi, W_XQ = 15 * Mi, W_XKV = 19 * Mi, W_XO = 27 * Mi, W_GU = 31 * Mi, W_DN = 53 * Mi;
constexpr size_t SZ_EVIN = (size_t)EV_IN * D, SZ_ODIN = (size_t)OD_IN * D, SZ_GU = (size_t)2 * DFF * D, SZ_DN = (size_t)DFF * D;

constexpr int RING_BYTES = 131072, MISC_OFF = 147456, LDS_BYTES = 147456 + 256;

#define LAS __attribute__((address_space(3)))
typedef unsigned short bf16;
typedef unsigned v4u __attribute__((ext_vector_type(4)));
typedef unsigned v2u __attribute__((ext_vector_type(2)));
typedef float f32x4 __attribute__((ext_vector_type(4)));
#define LDS_WAIT() asm volatile("s_waitcnt lgkmcnt(0)" ::: "memory")
__device__ __forceinline__ unsigned f2bf(float f) { unsigned u = __builtin_bit_cast(unsigned, f); return (u + 0x7fffu + ((u >> 16) & 1u)) >> 16; }
__device__ __forceinline__ unsigned pk2(float lo, float hi) { return f2bf(lo) | (f2bf(hi) << 16); }
__device__ __forceinline__ float bflo(unsigned w) { return __uint_as_float(w << 16); }
__device__ __forceinline__ float bfhi(unsigned w) { return __uint_as_float(w & 0xffff0000u); }
__device__ __forceinline__ float bf1(bf16 h) { return __uint_as_float((unsigned)h << 16); }
__device__ __forceinline__ float wave_sum(float v) {
#pragma unroll
    for (int o = 1; o < 64; o <<= 1) v += __shfl_xor(v, o);
    return v;
}
__device__ __forceinline__ float wave_max(float v) {
#pragma unroll
    for (int o = 1; o < 64; o <<= 1) v = fmaxf(v, __shfl_xor(v, o));
    return v;
}

__device__ __forceinline__ int hw_lane() { int l; asm volatile("v_mbcnt_lo_u32_b32 %0, -1, 0\n\tv_mbcnt_hi_u32_b32 %0, -1, %0" : "=v"(l)); return l; }
struct Args { const void* in[28]; float* out; unsigned char* ws; int pad0, pad1; };

typedef const unsigned char __attribute__((address_space(4)))* kargp_t;
struct Frame {
    LAS unsigned char* lds;
    int tid, lane, wave, vcu, G;
    kargp_t kp;
    __device__ __forceinline__ const float* inf(int k) const { return *(const float* const __attribute__((address_space(4)))*)(kp + 8 * k); }
    __device__ __forceinline__ const int* ini(int k) const { return *(const int* const __attribute__((address_space(4)))*)(kp + 8 * k); }
    __device__ __forceinline__ float* outp() const { return *(float* const __attribute__((address_space(4)))*)(kp + 224); }
    __device__ __forceinline__ unsigned char* wsb() const { return *(unsigned char* const __attribute__((address_space(4)))*)(kp + 232); }
    __device__ __forceinline__ float* wsf(size_t off) const { return (float*)(wsb() + off); }
    __device__ __forceinline__ bf16* wsh(size_t off) const { return (bf16*)(wsb() + off); }
    __device__ __forceinline__ void fresh() { lane = hw_lane(); asm volatile("" : "+s"(kp), "+v"(lane)); tid = wave * 64 + lane; }
};
enum { I_X = 0, I_MEM, I_POS, I_NORM_MIX, I_NORM_MEM_Q, I_NORM_MEM_KV, I_NORM_FFN, I_EV_W_IN, I_EV_Q_GAIN, I_EV_K_GAIN, I_EV_W_S, I_EV_B_S, I_EV_LN_G, I_EV_LN_B, I_EV_W_OUT,
       I_OD_W_IN, I_OD_W_G1, I_OD_W_G2, I_OD_B_G, I_OD_O_GAIN, I_OD_W_OUT, I_XA_W_Q, I_XA_W_KV, I_XA_Q_GAIN, I_XA_K_GAIN, I_XA_W_OUT, I_FFN_W_GU, I_FFN_W_DOWN };
#define F_X F.inf(I_X)
#define F_OUT F.outp()
#define F_MEMB ((bf16*)((unsigned char*)F.outp() + 32 * MiB))
#define F_W F.wsh(WS_W)
#define F_XB F.wsh(WS_XB)
#define F_CAT F.wsh(WS_CAT)
#define F_KXN F.wsh(WS_KXN)
#define F_VX F.wsh(WS_VX)
#define F_RA F.wsh(WS_RA)
#define F_ROPE F.wsf(WS_ROPE)
#define F_SS F.wsf(WS_SS)
#define F_T16 F.wsf(WS_T16)
#define F_KMP F.wsf(WS_KMP)
#define F_SSM F.wsf(WS_SSM)

struct P0Item { const float* W; const float* gain; bf16* WT; int K, N, item; bool f16; };
__device__ __forceinline__ void p0_load(const P0Item& d, int lane, float (&wv)[32], pg8::f32x4 (&gv)[2]) {
    const int nblk = d.N / 32, kb = d.item / nblk, nb = d.item % nblk, k0 = 64 * kb, n0 = 32 * nb;
    const float* wp = d.W + (size_t)(k0 + (lane >> 5)) * d.N + n0 + (lane & 31);
#pragma unroll
    for (int i = 0; i < 32; ++i) wv[i] = __builtin_nontemporal_load(wp + (size_t)(2 * i) * d.N);
    gv[0] = (pg8::f32x4){1.f, 1.f, 1.f, 1.f}; gv[1] = gv[0];
    if (d.gain) { const float* gp = d.gain + k0 + 8 * (lane & 7); gv[0] = *(const pg8::f32x4*)gp; gv[1] = *(const pg8::f32x4*)(gp + 4); }
}
__device__ __forceinline__ void p0_store(const P0Item& d, int lane, const float (&wv)[32], const pg8::f32x4 (&gv)[2], LAS float* scr) {
    const int nblk = d.N / 32, kb = d.item / nblk, nb = d.item % nblk, k0 = 64 * kb, n0 = 32 * nb;
#pragma unroll
    for (int i = 0; i < 32; ++i) scr[(2 * i + (lane >> 5)) * 33 + (lane & 31)] = wv[i];
    LDS_WAIT(); asm volatile("" ::: "memory");
    const int c = lane & 7;
#pragma unroll
    for (int j = 0; j < 4; ++j) { const int n = (lane >> 3) + 8 * j; const LAS float* sp = scr + (8 * c) * 33 + n;
        float e[8];
#pragma unroll
        for (int q = 0; q < 8; ++q) e[q] = sp[q * 33] * gv[q >> 2][q & 3];
        v4u o;
        if (d.f16) { o.x = pg8::cvt_pk_f16(e[0], e[1]); o.y = pg8::cvt_pk_f16(e[2], e[3]); o.z = pg8::cvt_pk_f16(e[4], e[5]); o.w = pg8::cvt_pk_f16(e[6], e[7]); }
        else { o.x = pg8::cvt_pk_bf16(e[0], e[1]); o.y = pg8::cvt_pk_bf16(e[2], e[3]); o.z = pg8::cvt_pk_bf16(e[4], e[5]); o.w = pg8::cvt_pk_bf16(e[6], e[7]); }
        *(v4u*)(d.WT + (size_t)(n0 + n) * d.K + k0 + 8 * c) = o; }
    LDS_WAIT(); asm volatile("" ::: "memory");
}
constexpr int P0_ITEMS_PRO = 4096 + 7040, P0_ITEMS_ALL = 32768;
__device__ __forceinline__ int p0_layer_first(int l) { return 4096 + (l >> 1) * 14336 + (l & 1) * 7040; }
__device__ __forceinline__ P0Item p0_decode(Frame& F, int r) {
    if (r < 4096) { const int l = r / 1024; return P0Item{F.inf(I_XA_W_KV) + (size_t)l * 2 * Mi, F.inf(I_NORM_MEM_KV) + l * D, F_W + W_XKV + l * 2 * Mi, D, 2 * D, r % 1024, false}; } r -= 4096;
    int l = 0; if (r >= 7040) { r -= 7040; l = 1; if (r >= 7296) { r -= 7296; l = 2; if (r >= 7040) { r -= 7040; l = 3; } } }
    const int li = l >> 1; const bool odd = (l & 1) != 0; const int nin = odd ? 1536 : 1280;
    if (r < nin) return odd ? P0Item{F.inf(I_OD_W_IN) + (size_t)li * SZ_ODIN, F.inf(I_NORM_MIX) + (2 * li + 1) * D, F_W + W_ODIN + li * SZ_ODIN, D, OD_IN, r, true}
                            : P0Item{F.inf(I_EV_W_IN) + (size_t)li * SZ_EVIN, F.inf(I_NORM_MIX) + (2 * li) * D, F_W + W_EVIN + li * SZ_EVIN, D, EV_IN, r, true};
    r -= nin;
    if (r < 512) return odd ? P0Item{F.inf(I_OD_W_OUT) + (size_t)li * Mi, nullptr, F_W + W_ODOUT + li * Mi, D, D, r, false} : P0Item{F.inf(I_EV_W_OUT) + (size_t)li * Mi, nullptr, F_W + W_EVOUT + li * Mi, D, D, r, false};
    r -= 512;
    if (r < 512) return P0Item{F.inf(I_XA_W_Q) + (size_t)l * Mi, F.inf(I_NORM_MEM_Q) + l * D, F_W + W_XQ + l * Mi, D, D, r, true};
    r -= 512;
    if (r < 512) return P0Item{F.inf(I_XA_W_OUT) + (size_t)l * Mi, nullptr, F_W + W_XO + l * Mi, D, D, r, false};
    r -= 512;
    if (r < 2816) return P0Item{F.inf(I_FFN_W_GU) + (size_t)l * SZ_GU, F.inf(I_NORM_FFN) + l * D, F_W + W_GU + l * SZ_GU, D, 2 * DFF, r, true};
    r -= 2816;
    return P0Item{F.inf(I_FFN_W_DOWN) + (size_t)l * SZ_DN, nullptr, F_W + W_DN + l * SZ_DN, DFF, D, r, false};
}
__device__ __forceinline__ void p0_convert(Frame& F, int first, int step, int end) {
    LAS float* scr = (LAS float*)(F.lds + F.wave * 16384);
    float wa[32], wb[32]; pg8::f32x4 ga[2], gb[2]; P0Item da, db;
    int it = first;
    if (it < end) { da = p0_decode(F, it); p0_load(da, F.lane, wa, ga); }
    for (; it < end; it += 2 * step) {
        const bool hb = it + step < end, ha = it + 2 * step < end;
        if (hb) { db = p0_decode(F, it + step); p0_load(db, F.lane, wb, gb); }
        p0_store(da, F.lane, wa, ga, scr);
        if (ha) { da = p0_decode(F, it + 2 * step); p0_load(da, F.lane, wa, ga); }
        if (hb) p0_store(db, F.lane, wb, gb, scr);
    }
}
__device__ __forceinline__ void row_to_bf16_ss(int lane, const float* xrow, bf16* orow, float* ssrow) {
    const f32x4* xr = (const f32x4*)xrow + lane; f32x4 v[4]; float s = 0.f;
#pragma unroll
    for (int j = 0; j < 4; ++j) { v[j] = xr[64 * j]; s += (v[j][0] * v[j][0] + v[j][1] * v[j][1]) + (v[j][2] * v[j][2] + v[j][3] * v[j][3]); }
    s = wave_sum(s);
    v2u* o8 = (v2u*)orow + lane;
#pragma unroll
    for (int j = 0; j < 4; ++j) { v2u w; w.x = pk2(v[j][0], v[j][1]); w.y = pk2(v[j][2], v[j][3]); o8[64 * j] = w; }
    if (lane < 16) ssrow[lane] = lane == 0 ? s : 0.f;
}
__device__ __forceinline__ void p0_prologue(Frame& F) {
    LAS float* scr = (LAS float*)(F.lds + F.wave * 16384);
    const int gw = F.vcu * NWAVES + F.wave, NGW = F.G * NWAVES;
    p0_convert(F, gw, NGW, F.G == 256 ? P0_ITEMS_PRO : P0_ITEMS_ALL);
    for (int m4 = gw * 4; m4 < M; m4 += NGW * 4) {
        const float* xs = F_X; bf16* xb = F_XB; float* ssp = F_SS;
        f32x4 v[4][4]; float sq[4];
#pragma unroll
        for (int r = 0; r < 4; ++r)
#pragma unroll
            for (int j = 0; j < 4; ++j) v[r][j] = ((const f32x4*)(xs + (size_t)(m4 + r) * D))[F.lane + 64 * j];
#pragma unroll
        for (int r = 0; r < 4; ++r) { float q = 0.f;
#pragma unroll
            for (int j = 0; j < 4; ++j) q += (v[r][j][0] * v[r][j][0] + v[r][j][1] * v[r][j][1]) + (v[r][j][2] * v[r][j][2] + v[r][j][3] * v[r][j][3]);
            sq[r] = wave_sum(q); }
#pragma unroll
        for (int r = 0; r < 4; ++r) { v2u* o8 = (v2u*)(xb + (size_t)(m4 + r) * D) + F.lane;
#pragma unroll
            for (int j = 0; j < 4; ++j) { v2u w; w.x = pg8::cvt_pk_f16(v[r][j][0], v[r][j][1]); w.y = pg8::cvt_pk_f16(v[r][j][2], v[r][j][3]); o8[64 * j] = w; }
            if (F.lane < 16) ssp[(size_t)(m4 + r) * 16 + F.lane] = F.lane == 0 ? sq[r] : 0.f; }
    }
    for (int m = gw; m < MM; m += NGW) row_to_bf16_ss(F.lane, F.inf(I_MEM) + (size_t)m * D, F_MEMB + (size_t)m * D, F_SSM + (size_t)m * 16);
    for (int idx = (F.vcu * NWAVES * 64) + F.tid; idx < M * 8; idx += F.G * NWAVES * 64) {
        const int token = idx >> 3, i = idx & 7;
        const float invf = __builtin_amdgcn_exp2f(-(float)i * 0.125f * 18.931568569324174f);
        const float ang = (float)F.ini(I_POS)[token] * invf;
        double t = (double)ang * 0.15915494309189535; t -= __builtin_floor(t);
        F_ROPE[(size_t)token * 16 + i] = __builtin_amdgcn_cosf((float)t);
        F_ROPE[(size_t)token * 16 + 8 + i] = __builtin_amdgcn_sinf((float)t);
    }
    { const float* w1 = F.inf(I_OD_W_G1); const float* nm = F.inf(I_NORM_MIX); _Float16* wd = (_Float16*)F.wsh(WS_W1G);
      for (int idx = (F.vcu * NWAVES * 64) + F.tid; idx < 2 * 16 * 1024; idx += F.G * NWAVES * 64) { const int li_ = idx >> 14, r = (idx >> 10) & 15, k = idx & 1023;
          wd[idx] = (_Float16)(w1[(size_t)li_ * D * 16 + k * 16 + r] * nm[(2 * li_ + 1) * D + k]); } }
    { const float* wsrc = F.inf(I_EV_W_S); bf16* wdst = F.wsh(WS_WSB);
      for (int idx = (F.vcu * NWAVES * 64) + F.tid; idx < 2 * 8 * 128 * 128; idx += F.G * NWAVES * 64) { const int i = (idx >> 7) & 127, j = idx & 127; wdst[idx] = (bf16)f2bf(j <= i ? wsrc[idx] : 0.f); } }
}

__device__ __forceinline__ void gate_t16(Frame& F, int l, int li) {
    (void)l;
    const _Float16* W1G = (const _Float16*)F.wsh(WS_W1G) + (size_t)li * 16 * 1024; const _Float16* XH = (const _Float16*)F_XB; float* T16 = F_T16; const float* SS = F_SS;
    const int lane = F.lane, c16 = lane & 15, kq = lane >> 4;
    const bool b256 = (F.G == 256);
    int tile = b256 ? ((F.vcu >> 5) * 128 + (F.vcu & 31) * 4 + F.wave) : (F.vcu * NWAVES + F.wave);
    const int stride = b256 ? 1024 : F.G * NWAVES;
    if (b256 && F.wave >= 4) return;
    for (; tile < M / 16; tile += stride) {
        const int token = tile * 16 + c16;
        const _Float16* ap = W1G + (size_t)c16 * 1024 + 8 * kq; const _Float16* bp = XH + (size_t)token * D + 8 * kq;
        pg8::f32x4 acc[4];
#pragma unroll
        for (int i = 0; i < 4; ++i) acc[i] = (pg8::f32x4){0.f, 0.f, 0.f, 0.f};
#pragma unroll 2
        for (int s8 = 0; s8 < 4; ++s8) {
            pg8::half8_t av[8], bv[8];
#pragma unroll
            for (int i = 0; i < 8; ++i) { av[i] = *(const pg8::half8_t*)(ap + 32 * (8 * s8 + i)); bv[i] = *(const pg8::half8_t*)(bp + 32 * (8 * s8 + i)); }
#pragma unroll
            for (int i = 0; i < 8; ++i) acc[i & 3] = __builtin_amdgcn_mfma_f32_16x16x32_f16(av[i], bv[i], acc[i & 3], 0, 0, 0);
        }
        const float rs = pg8::row_rstd(SS, token);
        const pg8::f32x4 o = ((acc[0] + acc[1]) + (acc[2] + acc[3])) * rs;
        *(pg8::f32x4*)(T16 + (size_t)token * 16 + 4 * kq) = o;
    }
}
typedef short bf16x8_t __attribute__((ext_vector_type(8)));
typedef short s16x4_t __attribute__((ext_vector_type(4)));
typedef float f32x16 __attribute__((ext_vector_type(16)));
__device__ __forceinline__ s16x4_t lds_tr(const LAS unsigned char* p) { return __builtin_bit_cast(s16x4_t, __builtin_amdgcn_ds_read_tr16_b64_v4i16((LAS s16x4_t*)p)); }
__device__ __forceinline__ bf16x8_t cat44(s16x4_t lo, s16x4_t hi) { return (bf16x8_t){lo[0], lo[1], lo[2], lo[3], hi[0], hi[1], hi[2], hi[3]}; }
__device__ __forceinline__ bf16x8_t packf8(const float* v) { const pg8::u32x4 w = pg8::pack8(v); return __builtin_bit_cast(bf16x8_t, w); }
__device__ __forceinline__ bf16 cvt1(float x) { return (bf16)(pg8::cvt_pk_bf16(x, 0.f) & 0xffffu); }
__device__ __forceinline__ int crow(int r, int hi) { return (r & 3) + 8 * (r >> 2) + 4 * hi; }

constexpr int MOBA_VP = 192;
__device__ __forceinline__ void moba_mfma(Frame& F) {
    const bf16* Qg = F_RA; const bf16* Kg = Qg + 8 * Mi; const bf16* Vg = Qg + 16 * Mi; bf16* CAT = F_CAT; const float* KMP = F_KMP;
    const int tid = F.tid, lane = F.lane, w = F.wave, r32 = lane & 31, h = lane >> 5;
    const float C2 = 0.125f * 1.4426950408889634f;
    const int srow = tid >> 3, sch = tid & 7;
    const unsigned kst = (unsigned)(srow * 128 + ((sch ^ (srow & 7)) << 4)), vst = (unsigned)(srow * MOBA_VP + sch * 16);
    const int tq = (lane & 15) >> 2, tp = lane & 3, tblk = (lane >> 4) & 1;
    for (int wgu = F.vcu; wgu < 256; wgu += F.G) {
        const int b = wgu >> 5, head = (wgu >> 2) & 7, s = wgu & 3;
        for (int half = 0; half < 2; ++half) {
            const int qb = half == 0 ? 7 - s : s;
            const int token = b * SEQ + qb * 256 + 32 * w + r32;
            const bf16* qrow = Qg + (size_t)token * 512 + head * 64;
            bf16x8_t qf[4];
#pragma unroll
            for (int s4 = 0; s4 < 4; ++s4) qf[s4] = *(const bf16x8_t*)(qrow + 16 * s4 + 8 * h);
            const int nt = 2 * (qb + 1);
            const bf16* kbase = Kg + (size_t)(b * SEQ + srow) * 512 + head * 64 + sch * 8;
            const bf16* vbase = Vg + (size_t)(b * SEQ + srow) * 512 + head * 64 + sch * 8;
#define MOBA_LD(T, A0, A1, B0, B1) do { A0 = *(const v4u*)(kbase + (size_t)(T) * 128 * 512); A1 = *(const v4u*)(kbase + (size_t)((T) * 128 + 64) * 512); \
                                        B0 = *(const v4u*)(vbase + (size_t)(T) * 128 * 512); B1 = *(const v4u*)(vbase + (size_t)((T) * 128 + 64) * 512); } while (0)
            v4u ka0, ka1, va0, va1, kb0 = {0u, 0u, 0u, 0u}, kb1 = kb0, vb0 = kb0, vb1 = kb0;
            MOBA_LD(0, ka0, ka1, va0, va1);
            if (nt > 1) MOBA_LD(1, kb0, kb1, vb0, vb1);
            float g[7];
#pragma unroll
            for (int j = 0; j < 7; ++j) {
                g[j] = -1e30f;
                if (j < qb) {
                    const float* k0 = KMP + (size_t)((b * 8 + j) * 2) * 512 + head * 64; float part = 0.f;
#pragma unroll
                    for (int s4 = 0; s4 < 4; ++s4) {
                        const f32x4 a0 = *(const f32x4*)(k0 + 16 * s4 + 8 * h), a1 = *(const f32x4*)(k0 + 16 * s4 + 8 * h + 4);
                        const f32x4 b0 = *(const f32x4*)(k0 + 512 + 16 * s4 + 8 * h), b1 = *(const f32x4*)(k0 + 512 + 16 * s4 + 8 * h + 4);
#pragma unroll
                        for (int e = 0; e < 4; ++e) { part += bf1((bf16)qf[s4][e]) * (a0[e] + b0[e]); part += bf1((bf16)qf[s4][4 + e]) * (a1[e] + b1[e]); }
                    }
                    g[j] = part + __shfl_xor(part, 32);
                }
            }
            unsigned selm = 0;
#pragma unroll
            for (int j = 0; j < 7; ++j) if (j < qb) { int cnt = 0;
#pragma unroll
                for (int jj = 0; jj < 7; ++jj) if (jj != j && jj < qb) cnt += (g[jj] > g[j] || (g[jj] == g[j] && jj < j)) ? 1 : 0;
                if (cnt < 3) selm |= 1u << j; }
            float mrun = -1e30f, lrun = 0.f; f32x16 o[2];
#pragma unroll
            for (int r = 0; r < 16; ++r) { o[0][r] = 0.f; o[1][r] = 0.f; }
#define MOBA_ST(BUF, A0, A1, B0, B1) do { *(LAS v4u*)(F.lds + (BUF) + kst) = A0; *(LAS v4u*)(F.lds + (BUF) + 8192 + kst) = A1; \
                                          *(LAS v4u*)(F.lds + (BUF) + 16384 + vst) = B0; *(LAS v4u*)(F.lds + (BUF) + 16384 + 64 * MOBA_VP + vst) = B1; } while (0)
            MOBA_ST(0, ka0, ka1, va0, va1);
            __syncthreads();
            int bcur = 0;
            for (int tt = 0; tt < nt; ++tt) {
                const int j = tt >> 1, kt2 = tt & 1;
                const int bnxt = bcur == 81920 ? 0 : bcur + 40960;
                if (tt + 2 < nt) MOBA_LD(tt + 2, ka0, ka1, va0, va1);
                if (tt + 1 < nt) MOBA_ST(bnxt, kb0, kb1, vb0, vb1);
                const bool own = (j == qb);
                const bool mysel = own || ((selm >> j) & 1u);
                int nact = 4;
                if (own) { nact = w - 4 * kt2 + 1; nact = nact < 0 ? 0 : (nact > 4 ? 4 : nact); }
                else if (__ballot(mysel) == 0ull) nact = 0;
                if (nact > 0) {
                    const LAS unsigned char* kb = F.lds + bcur; const LAS unsigned char* vb = F.lds + bcur + 16384;
                    f32x16 st[4];
                    __builtin_amdgcn_s_setprio(1);
#pragma unroll
                    for (int mt = 0; mt < 4; ++mt) {
                        if (mt < nact) {
#pragma unroll
                            for (int r = 0; r < 16; ++r) st[mt][r] = 0.f;
                            const int row = 32 * mt + r32;
#pragma unroll
                            for (int s4 = 0; s4 < 4; ++s4) { const bf16x8_t kf = *(const LAS bf16x8_t*)(kb + row * 128 + (((2 * s4 + h) ^ (row & 7)) << 4));
                                st[mt] = __builtin_amdgcn_mfma_f32_32x32x16_bf16(kf, qf[s4], st[mt], 0, 0, 0); }
                            if (!own) { if (!mysel) {
#pragma unroll
                                for (int r = 0; r < 16; ++r) st[mt][r] = -INFINITY; } }
                            else if (128 * kt2 + 32 * mt + 31 > 32 * w) {
                                const int qi = 32 * w + r32;
#pragma unroll
                                for (int r = 0; r < 16; ++r) if (128 * kt2 + 32 * mt + crow(r, h) > qi) st[mt][r] = -INFINITY;
                            }
                        } else {
#pragma unroll
                            for (int r = 0; r < 16; ++r) st[mt][r] = -INFINITY;
                        }
                    }
                    __builtin_amdgcn_s_setprio(0);
                    float mx = fmaxf(fmaxf(st[0][0], st[1][0]), fmaxf(st[2][0], st[3][0]));
#pragma unroll
                    for (int r = 1; r < 16; ++r) mx = fmaxf(mx, fmaxf(fmaxf(st[0][r], st[1][r]), fmaxf(st[2][r], st[3][r])));
                    mx = fmaxf(mx, __shfl_xor(mx, 32));
                    const float mnew = fmaxf(mrun, mx);
                    if (__ballot(mnew > mrun) != 0ull) {
                        const float alpha = __builtin_amdgcn_exp2f((mrun - mnew) * C2);
                        lrun *= alpha;
#pragma unroll
                        for (int r = 0; r < 16; ++r) { o[0][r] *= alpha; o[1][r] *= alpha; }
                    }
                    mrun = mnew; const float mc = mnew * C2;
                    float psum = 0.f;
#pragma unroll
                    for (int mt = 0; mt < 4; ++mt)
#pragma unroll
                        for (int r = 0; r < 16; ++r) { const float p = __builtin_amdgcn_exp2f(__builtin_fmaf(st[mt][r], C2, -mc)); st[mt][r] = p; psum += p; }
                    lrun += psum;
                    __builtin_amdgcn_s_setprio(1);
#pragma unroll
                    for (int s8 = 0; s8 < 8; ++s8) {
                        const int mt = s8 >> 1, rb = 8 * (s8 & 1);
                        if (mt < nact) {
                            float pv8[8];
#pragma unroll
                            for (int e = 0; e < 8; ++e) pv8[e] = st[mt][rb + e];
                            const bf16x8_t pf = packf8(pv8);
                            const int krow = 32 * mt + 16 * (s8 & 1) + 4 * h + tq;
#pragma unroll
                            for (int t = 0; t < 2; ++t) {
                                const LAS unsigned char* ap = vb + krow * MOBA_VP + (32 * t + 16 * tblk + 4 * tp) * 2;
                                const bf16x8_t vf = cat44(lds_tr(ap), lds_tr(ap + 8 * MOBA_VP));
                                o[t] = __builtin_amdgcn_mfma_f32_32x32x16_bf16(vf, pf, o[t], 0, 0, 0);
                            }
                        }
                    }
                    __builtin_amdgcn_s_setprio(0);
                }
                kb0 = ka0; kb1 = ka1; vb0 = va0; vb1 = va1; bcur = bnxt;
                __syncthreads();
            }
#undef MOBA_LD
#undef MOBA_ST
            const float ltot = lrun + __shfl_xor(lrun, 32), inv = 1.0f / ltot;
            bf16* orow = CAT + (size_t)token * 1024 + head * 64;
#pragma unroll
            for (int t = 0; t < 2; ++t)
#pragma unroll
                for (int rg = 0; rg < 4; ++rg) { v2u wv; wv.x = pg8::cvt_pk_bf16(o[t][4 * rg] * inv, o[t][4 * rg + 1] * inv); wv.y = pg8::cvt_pk_bf16(o[t][4 * rg + 2] * inv, o[t][4 * rg + 3] * inv);
                    *(v2u*)(orow + 32 * t + 8 * rg + 4 * h) = wv; }
        }
    }
}
__device__ __forceinline__ void gmlp_mfma(Frame& F, int li) {
    const bf16* U = F_RA + 24 * Mi; const bf16* VN = F_RA + 32 * Mi; bf16* CAT = F_CAT;
    const bf16* WSB = F.wsh(WS_WSB) + (size_t)li * 8 * 128 * 128; const float* bs = F.inf(I_EV_B_S) + (size_t)li * 8 * 128;
    const int lane = F.lane, r32 = lane & 31, h = lane >> 5;
    const int tq = (lane & 15) >> 2, tp = lane & 3, tblk = (lane >> 4) & 1;
    const int pr = F.wave >> 1, sub = F.wave & 1;
    LAS unsigned char* wl = F.lds + pr * 16384;
    for (int wgu = F.vcu; wgu < 256; wgu += F.G) {
        const int uid = (wgu & 31) * 4 + pr, chunk = (wgu >> 5) * 16 + (uid >> 3), g = uid & 7; const int tok0 = chunk * 128;
        v4u vimg[8];
#pragma unroll
        for (int i = 0; i < 8; ++i) { const int n = lane + 64 * (2 * i + sub), row = n >> 3, ch = n & 7; vimg[i] = *(const v4u*)(VN + (size_t)(tok0 + row) * 512 + g * 64 + ch * 8); }
        const bf16* wsg = WSB + (size_t)g * 128 * 128;
        bf16x8_t bq[2][8];
#pragma unroll
        for (int ii = 0; ii < 2; ++ii) {
            const int itile = ii == 0 ? sub : 3 - sub, icol = 32 * itile + r32, nks = 2 * itile + 2;
#pragma unroll
            for (int ks = 0; ks < 8; ++ks) { bq[ii][ks] = (bf16x8_t){0, 0, 0, 0, 0, 0, 0, 0}; if (ks < nks) bq[ii][ks] = *(const bf16x8_t*)(wsg + (size_t)icol * 128 + 16 * ks + 8 * h); }
        }
#pragma unroll
        for (int i = 0; i < 8; ++i) { const int n = lane + 64 * (2 * i + sub), row = n >> 3, ch = n & 7; *(LAS v4u*)(wl + row * 128 + ch * 16) = vimg[i]; }
        __syncthreads();
#pragma unroll
        for (int ii = 0; ii < 2; ++ii) {
            const int itile = ii == 0 ? sub : 3 - sub, nks = 2 * itile + 2;
            const int icol = 32 * itile + r32;
            const float bsv = bs[g * 128 + icol];
            const size_t tok = (size_t)(tok0 + icol);
            v2u uw[2][4];
#pragma unroll
            for (int t = 0; t < 2; ++t)
#pragma unroll
                for (int rg = 0; rg < 4; ++rg) uw[t][rg] = *(const v2u*)(U + tok * 512 + g * 64 + 32 * t + 8 * rg + 4 * h);
            f32x16 acc[2];
#pragma unroll
            for (int r = 0; r < 16; ++r) { acc[0][r] = 0.f; acc[1][r] = 0.f; }
#pragma unroll
            for (int ks = 0; ks < 8; ++ks) {
                if (ks < nks) {
#pragma unroll
                    for (int t = 0; t < 2; ++t) {
                        const LAS unsigned char* ap = wl + (16 * ks + 8 * h + tq) * 128 + (32 * t + 16 * tblk + 4 * tp) * 2;
                        const bf16x8_t af = cat44(lds_tr(ap), lds_tr(ap + 4 * 128));
                        acc[t] = __builtin_amdgcn_mfma_f32_32x32x16_bf16(af, bq[ii][ks], acc[t], 0, 0, 0);
                    }
                }
            }
#pragma unroll
            for (int t = 0; t < 2; ++t)
#pragma unroll
                for (int rg = 0; rg < 4; ++rg) {
                    const int d = 32 * t + 8 * rg + 4 * h;
                    v2u wv; wv.x = pg8::cvt_pk_bf16(bflo(uw[t][rg].x) * (acc[t][4 * rg] + bsv), bfhi(uw[t][rg].x) * (acc[t][4 * rg + 1] + bsv));
                    wv.y = pg8::cvt_pk_bf16(bflo(uw[t][rg].y) * (acc[t][4 * rg + 2] + bsv), bfhi(uw[t][rg].y) * (acc[t][4 * rg + 3] + bsv));
                    *(v2u*)(CAT + tok * 1024 + 512 + g * 64 + d) = wv;
                }
        }
        __syncthreads();
    }
}
__device__ __forceinline__ void xattn_dma_image(Frame& F, const bf16* img) {
    unsigned voff = (unsigned)F.tid * 16u; asm volatile("" : "+v"(voff));
    const unsigned long long pv = (unsigned long long)img;
    unsigned plo = (unsigned)__builtin_amdgcn_readfirstlane((int)(unsigned)pv); const unsigned phi = (unsigned)__builtin_amdgcn_readfirstlane((int)(unsigned)(pv >> 32));
#pragma unroll
    for (int i = 0; i < 16; ++i) { const unsigned char* p = (const unsigned char*)(((unsigned long long)phi << 32) | plo);
        __builtin_amdgcn_global_load_lds((const unsigned*)(p + voff), (LAS unsigned*)(F.lds + F.wave * 1024 + i * 8192), 16, 0, 0);
        plo += 8192u; asm volatile("" : "+s"(plo)); }
}
__device__ __forceinline__ void xattn_mfma(Frame& F, int l, const pg8::StaticOrder& SO) {
    const bf16* QX = F_RA; bf16* CAT = F_CAT;
    const bf16* KX = F_KXN + (size_t)l * 32 * 65536; const bf16* VXp = F_VX + (size_t)l * 32 * 65536;
    const int lane = F.lane, w = F.wave, r32 = lane & 31, h = lane >> 5;
    const int tq = (lane & 15) >> 2, tp = lane & 3, tblk = (lane >> 4) & 1;
    pg8::Unit uu;
    for (int ui = 0; SO.next(ui, uu); ++ui) {
        const int pm = uu.pm, head = uu.pn, b = pm >> 3;
        const int token = pm * 256 + 32 * w + r32;
        xattn_dma_image(F, KX + (size_t)(b * 4 + head) * 65536);
        const bf16* qtile = QX + (size_t)(((pm * 4 + head) * 8 + w) * 16) * 512 + r32 * 16 + 8 * h;
        float ss = 0.f;
        f32x16 st[8];
#pragma unroll
        for (int mt = 0; mt < 8; ++mt)
#pragma unroll
            for (int r = 0; r < 16; ++r) st[mt][r] = 0.f;
        asm volatile("s_waitcnt vmcnt(0)" ::: "memory");
        __syncthreads();
#pragma unroll
        for (int qh = 0; qh < 2; ++qh) {
            bf16x8_t qf[8];
#pragma unroll
            for (int s = 0; s < 8; ++s) { qf[s] = *(const bf16x8_t*)(qtile + (8 * qh + s) * 512);
#pragma unroll
                for (int e = 0; e < 8; ++e) { const float qv = bf1((bf16)qf[s][e]); ss += qv * qv; } }
            __builtin_amdgcn_s_setprio(1);
#pragma unroll
            for (int mt = 0; mt < 8; ++mt) {
                const int row = 32 * mt + r32;
#pragma unroll
                for (int s = 0; s < 8; ++s) { const bf16x8_t kf = *(const LAS bf16x8_t*)(F.lds + row * 512 + (((16 * qh + 2 * s + h) ^ (row & 15)) << 4));
                    st[mt] = __builtin_amdgcn_mfma_f32_32x32x16_bf16(kf, qf[s], st[mt], 0, 0, 0); }
            }
            __builtin_amdgcn_s_setprio(0);
            asm volatile("" ::: "memory");
        }
        ss += __shfl_xor(ss, 32);
        const float cs = __builtin_amdgcn_rsqf(ss * (1.0f / 256.0f) + EPSF) * (0.0625f * 1.4426950408889634f);
        __syncthreads();
        xattn_dma_image(F, VXp + (size_t)(b * 4 + head) * 65536);
        float mx = st[0][0];
#pragma unroll
        for (int mt = 0; mt < 8; ++mt)
#pragma unroll
            for (int r = 0; r < 16; ++r) mx = fmaxf(mx, st[mt][r]);
        mx = fmaxf(mx, __shfl_xor(mx, 32));
        const float mc = mx * cs; float psum = 0.f;
        bf16x8_t pf[16];
#pragma unroll
        for (int mt = 0; mt < 8; ++mt) {
#pragma unroll
            for (int r = 0; r < 16; ++r) { const float p = __builtin_amdgcn_exp2f(__builtin_fmaf(st[mt][r], cs, -mc)); st[mt][r] = p; psum += p; }
#pragma unroll
            for (int hh = 0; hh < 2; ++hh) { float pv8[8];
#pragma unroll
                for (int e = 0; e < 8; ++e) pv8[e] = st[mt][8 * hh + e];
                pf[2 * mt + hh] = packf8(pv8); }
        }
        psum += __shfl_xor(psum, 32);
        const float inv = 1.0f / psum;
        asm volatile("s_waitcnt vmcnt(0)" ::: "memory");
        __syncthreads();
        v2u opk[2][16];
#pragma unroll
        for (int dh = 0; dh < 2; ++dh) {
            f32x16 o[4];
#pragma unroll
            for (int t = 0; t < 4; ++t)
#pragma unroll
                for (int r = 0; r < 16; ++r) o[t][r] = 0.f;
            int vrow = (4 * h + tq) * 512 + 8 * (tp & 1), vch = 2 * tblk + (tp >> 1), vx = tq << 2; asm volatile("" : "+v"(vrow), "+v"(vch), "+v"(vx));
            __builtin_amdgcn_s_setprio(1);
#pragma unroll
            for (int s = 0; s < 16; ++s) {
#pragma unroll
                for (int t = 0; t < 4; ++t) {
                    const LAS unsigned char* ap = F.lds + vrow + (16 * s) * 512 + (((16 * dh + 4 * t + vch) ^ vx) << 4);
                    const bf16x8_t vf = cat44(lds_tr(ap), lds_tr(ap + 8 * 512));
                    o[t] = __builtin_amdgcn_mfma_f32_32x32x16_bf16(vf, pf[s], o[t], 0, 0, 0);
                }
            }
            __builtin_amdgcn_s_setprio(0);
#pragma unroll
            for (int t = 0; t < 4; ++t)
#pragma unroll
                for (int rg = 0; rg < 4; ++rg) { opk[dh][4 * t + rg].x = pg8::cvt_pk_bf16(o[t][4 * rg] * inv, o[t][4 * rg + 1] * inv); opk[dh][4 * t + rg].y = pg8::cvt_pk_bf16(o[t][4 * rg + 2] * inv, o[t][4 * rg + 3] * inv); }
        }
        __syncthreads();
        { LAS unsigned char* og_ = F.lds + w * 16384;
          int lz = F.lane; asm volatile("" : "+v"(lz));
          const int rr = lz & 31, hz = lz >> 5;
#pragma unroll
          for (int dh = 0; dh < 2; ++dh)
#pragma unroll
              for (int t = 0; t < 4; ++t)
#pragma unroll
                  for (int rg = 0; rg < 4; ++rg) { const int ch = 16 * dh + 4 * t + rg;
                      *(LAS v2u*)(og_ + rr * 512 + ((ch ^ rr) << 4) + 8 * hz) = opk[dh][4 * t + rg]; }
          LDS_WAIT(); asm volatile("" ::: "memory");
          bf16* obase = CAT + (size_t)(pm * 256 + 32 * w) * 1024 + head * 256;
#pragma unroll
          for (int i = 0; i < 16; ++i) { const int row = 2 * i + hz, ch = rr;
              *(v4u*)(obase + (unsigned)(row * 1024 + ch * 8)) = *(const LAS v4u*)(og_ + row * 512 + ((ch ^ row) << 4)); }
          LDS_WAIT(); asm volatile("" ::: "memory"); }
        __syncthreads();
    }
}

constexpr int GL_QIN = 0, GL_KIN = 16384, GL_KST = 32768, GL_KSTP = 320, GL_VCH = 53248, GL_VP = 576, GL_TOT = 90112, GL_DEC = 92160, GL_T16 = 92672;
constexpr size_t WS_DEC = WS_KMP + 512 * 1024;
__device__ __forceinline__ void gla_g1(Frame& F, int li) {
    bf16* PROJ = F_RA; bf16* QG = F_RA + 48 * Mi; bf16* CAT = F_CAT; const float* T16 = F_T16; float* DS = F_OUT; float* DECG = F.wsf(WS_DEC);
    const float* w2 = F.inf(I_OD_W_G2) + (size_t)li * 16 * 512; const float* bg = F.inf(I_OD_B_G) + (size_t)li * 512;
    const int tid = F.tid, w = F.wave;
    const int d = tid & 127, iq = __builtin_amdgcn_readfirstlane(tid >> 7);
    LAS unsigned char* L = F.lds;
    LAS float* TOT = (LAS float*)(L + GL_TOT); LAS float* DECL = (LAS float*)(L + GL_DEC);
    for (int u = F.vcu; u < 256; u += F.G) {
        const int b = u >> 5, hh = (u >> 3) & 3, sc = u & 7; const int T0 = b * SEQ + sc * 256;
        float w2c[16];
#pragma unroll
        for (int r = 0; r < 16; ++r) w2c[r] = w2[r * 512 + hh * 128 + d];
        const float bgc = bg[hh * 128 + d];
        float Bprev = 0.f;
        { const int n = tid; const f32x4* src = (const f32x4*)(T16 + (size_t)T0 * 16);
#pragma unroll
          for (int i2 = 0; i2 < 2; ++i2) *(LAS f32x4*)(L + GL_T16 + (n + 512 * i2) * 16) = src[n + 512 * i2]; }
        __syncthreads();
        f32x16 S[4];
#pragma unroll
        for (int t = 0; t < 4; ++t)
#pragma unroll
            for (int r = 0; r < 16; ++r) S[t][r] = 0.f;
        unsigned short qraw[16], kraw[16]; v4u vreg[4];
#define GL_LOADS_Q(TOK) do { const bf16* qb_ = PROJ + (size_t)((TOK) + 16 * iq) * OD_IN + hh * 128;     \
        _Pragma("unroll") for (int ii = 0; ii < 16; ++ii) { qraw[ii] = qb_[(unsigned)(ii * OD_IN + d)]; kraw[ii] = qb_[(unsigned)(ii * OD_IN + 512 + d)]; } } while (0)
#define GL_LOADS(TOK) do { const bf16* vb_ = PROJ + (size_t)(TOK) * OD_IN + 1024 + hh * 256; \
        _Pragma("unroll") for (int i2 = 0; i2 < 4; ++i2) { const int n_ = tid + 512 * i2; vreg[i2] = *(const v4u*)(vb_ + (unsigned)((n_ >> 5) * OD_IN + (n_ & 31) * 8)); } } while (0)
        GL_LOADS(T0);
        for (int c = 0; c < 4; ++c) {
            const int tok0 = T0 + 64 * c;
            GL_LOADS_Q(tok0);
            float bl[16]; float run = 0.f;
#pragma unroll
            for (int ii = 0; ii < 16; ++ii) {
                const LAS f32x4* t16 = (const LAS f32x4*)(L + GL_T16 + (64 * c + 16 * iq + ii) * 64); float z = bgc;
#pragma unroll
                for (int r4 = 0; r4 < 4; ++r4) { const f32x4 tv = t16[r4]; z += tv[0] * w2c[4 * r4] + tv[1] * w2c[4 * r4 + 1] + tv[2] * w2c[4 * r4 + 2] + tv[3] * w2c[4 * r4 + 3]; }
                const float ls = fminf(z, 0.f) - __logf(1.0f + __expf(-fabsf(z)));
                run += ls * (1.0f / 16.0f); bl[ii] = run;
            }
            TOT[iq * 128 + d] = run;
#pragma unroll
            for (int i2 = 0; i2 < 4; ++i2) { const int n = tid + 512 * i2, row = n >> 5, ch = n & 31; *(LAS v4u*)(L + GL_VCH + row * GL_VP + ch * 16) = vreg[i2]; }
            __syncthreads();
            float off = 0.f, blast = 0.f;
#pragma unroll
            for (int q4 = 0; q4 < 4; ++q4) { const float tv = TOT[q4 * 128 + d]; blast += tv; if (q4 < iq) off += tv; }
            const float eB = __expf(Bprev), eL = __expf(blast);
#pragma unroll
            for (int ii = 0; ii < 16; ++ii) {
                const int row = 16 * iq + ii;
                const float bb = off + bl[ii];
                const float qv = bf1(qraw[ii]), kv = bf1(kraw[ii]);
                const float e = __expf(bb), ei = __builtin_amdgcn_rcpf(e);
                const unsigned swz = (unsigned)(row * 256 + ((((d >> 3) ^ (row & 15)) << 4) | ((d & 7) * 2)));
                *(LAS bf16*)(L + GL_QIN + swz) = cvt1(qv * e);
                *(LAS bf16*)(L + GL_KIN + swz) = cvt1(kv * ei);
                *(LAS bf16*)(L + GL_KST + row * GL_KSTP + d * 2) = cvt1(kv * ei * eL);
                QG[(size_t)(tok0 + row) * 512 + hh * 128 + d] = cvt1(qv * e * eB);
            }
            if (iq == 0) DECL[d] = eL;
            Bprev += blast;
            __syncthreads();
            if (c < 3) GL_LOADS(tok0 + 64);
            int lane = F.lane; asm volatile("" : "+v"(lane));
            const int r32 = lane & 31, h = lane >> 5, tq = (lane & 15) >> 2, tp = lane & 3, tblk = (lane >> 4) & 1;
            bf16x8_t aT[3][2];
#pragma unroll
            for (int tile = 0; tile < 3; ++tile) {
                const int jt = tile == 2 ? 1 : 0, it = tile == 0 ? 0 : 1;
                f32x16 a;
#pragma unroll
                for (int r = 0; r < 16; ++r) a[r] = 0.f;
                const int rowj = 32 * jt + r32, rowi = 32 * it + r32;
#pragma unroll
                for (int s8 = 0; s8 < 8; ++s8) {
                    const bf16x8_t kf = *(const LAS bf16x8_t*)(L + GL_KIN + rowj * 256 + (((2 * s8 + h) ^ (rowj & 15)) << 4));
                    const bf16x8_t qf = *(const LAS bf16x8_t*)(L + GL_QIN + rowi * 256 + (((2 * s8 + h) ^ (rowi & 15)) << 4));
                    a = __builtin_amdgcn_mfma_f32_32x32x16_bf16(kf, qf, a, 0, 0, 0);
                }
                if (jt == it) {
#pragma unroll
                    for (int r = 0; r < 16; ++r) if (crow(r, h) > r32) a[r] = 0.f;
                }
                float p8[8];
#pragma unroll
                for (int e = 0; e < 8; ++e) p8[e] = a[e];
                aT[tile][0] = packf8(p8);
#pragma unroll
                for (int e = 0; e < 8; ++e) p8[e] = a[8 + e];
                aT[tile][1] = packf8(p8);
            }
#pragma unroll
            for (int it = 0; it < 2; ++it) {
                f32x16 o;
#pragma unroll
                for (int r = 0; r < 16; ++r) o[r] = 0.f;
#pragma unroll
                for (int jt = 0; jt <= it; ++jt) {
                    const int tile = jt == 0 ? it : 2;
#pragma unroll
                    for (int s2 = 0; s2 < 2; ++s2) {
                        const LAS unsigned char* ap = L + GL_VCH + (32 * jt + 16 * s2 + 4 * h + tq) * GL_VP + (32 * w + 16 * tblk + 4 * tp) * 2;
                        const bf16x8_t vf = cat44(lds_tr(ap), lds_tr(ap + 8 * GL_VP));
                        o = __builtin_amdgcn_mfma_f32_32x32x16_bf16(vf, aT[tile][s2], o, 0, 0, 0);
                    }
                }
                const int rowi = 32 * it + r32;
#pragma unroll
                for (int dkt = 0; dkt < 4; ++dkt)
#pragma unroll
                    for (int s2 = 0; s2 < 2; ++s2) {
                        float p8[8];
#pragma unroll
                        for (int e = 0; e < 8; ++e) p8[e] = S[dkt][8 * s2 + e];
                        const bf16x8_t sf = packf8(p8);
                        const int chk = 4 * dkt + 2 * s2;
                        const s16x4_t q0 = *(const LAS s16x4_t*)(L + GL_QIN + rowi * 256 + ((chk ^ (rowi & 15)) << 4) + 8 * h);
                        const s16x4_t q1 = *(const LAS s16x4_t*)(L + GL_QIN + rowi * 256 + (((chk + 1) ^ (rowi & 15)) << 4) + 8 * h);
                        o = __builtin_amdgcn_mfma_f32_32x32x16_bf16(sf, cat44(q0, q1), o, 0, 0, 0);
                    }
                bf16* orow = CAT + (size_t)(tok0 + rowi) * 1024 + hh * 256 + 32 * w + 4 * h;
#pragma unroll
                for (int rg = 0; rg < 4; ++rg) { v2u wv; wv.x = pg8::cvt_pk_bf16(o[4 * rg], o[4 * rg + 1]); wv.y = pg8::cvt_pk_bf16(o[4 * rg + 2], o[4 * rg + 3]); *(v2u*)(orow + 8 * rg) = wv; }
            }
#pragma unroll
            for (int dkt = 0; dkt < 4; ++dkt)
#pragma unroll
                for (int r = 0; r < 16; ++r) S[dkt][r] *= DECL[32 * dkt + crow(r, h)];
#pragma unroll
            for (int s4 = 0; s4 < 4; ++s4) {
                const LAS unsigned char* bp = L + GL_VCH + (16 * s4 + 8 * h + tq) * GL_VP + (32 * w + 16 * tblk + 4 * tp) * 2;
                const bf16x8_t vfb = cat44(lds_tr(bp), lds_tr(bp + 4 * GL_VP));
#pragma unroll
                for (int dkt = 0; dkt < 4; ++dkt) {
                    const LAS unsigned char* ak = L + GL_KST + (16 * s4 + 8 * h + tq) * GL_KSTP + (32 * dkt + 16 * tblk + 4 * tp) * 2;
                    const bf16x8_t kfa = cat44(lds_tr(ak), lds_tr(ak + 4 * GL_KSTP));
                    S[dkt] = __builtin_amdgcn_mfma_f32_32x32x16_bf16(kfa, vfb, S[dkt], 0, 0, 0);
                }
            }
            __syncthreads();
        }
        if (iq == 0) DECG[u * 128 + d] = __expf(Bprev);
#undef GL_LOADS
#undef GL_LOADS_Q
        { bf16* dsu = (bf16*)DS + (size_t)u * 32768 + (size_t)w * 4096 + (size_t)F.lane * 16;
#pragma unroll
          for (int dkt = 0; dkt < 4; ++dkt) {
              float t8[8];
#pragma unroll
              for (int hx = 0; hx < 2; ++hx) {
#pragma unroll
                  for (int e = 0; e < 8; ++e) t8[e] = S[dkt][8 * hx + e];
                  *(pg8::u32x4*)(dsu + dkt * 1024 + 8 * hx) = pg8::pack8(t8); } } }
    }
}
__device__ __forceinline__ void gla_g2(Frame& F, int li) {
    const bf16* PROJ = F_RA; const bf16* QG = F_RA + 48 * Mi; bf16* CAT = F_CAT; const bf16* DS = (const bf16*)F_OUT; const float* DECG = F.wsf(WS_DEC);
    const float* og = F.inf(I_OD_O_GAIN) + (size_t)li * 1024;
    const int w = F.wave;
    LAS float* red = (LAS float*)F.lds;
    for (int u = F.vcu; u < 256; u += F.G) {
        int lane = F.lane; asm volatile("" : "+v"(lane));
        const int r32 = lane & 31, h = lane >> 5;
        const int b = u >> 5, hh = (u >> 3) & 3, sc = u & 7; const int T0 = b * SEQ + sc * 256;
        f32x16 S[4], cur[4];
#pragma unroll
        for (int t = 0; t < 4; ++t)
#pragma unroll
            for (int r = 0; r < 16; ++r) { S[t][r] = 0.f; cur[t][r] = 0.f; }
        unsigned lo_ = (unsigned)(w * 4096 + lane * 16); asm volatile("" : "+v"(lo_));
#define G2_LOAD(DST, PTR) do { _Pragma("unroll") for (int dkt = 0; dkt < 4; ++dkt) _Pragma("unroll") for (int hx = 0; hx < 2; ++hx) { const v4u t4 = *(const v4u*)((PTR) + dkt * 1024 + 8 * hx); \
            DST[dkt][8 * hx] = bflo(t4.x); DST[dkt][8 * hx + 1] = bfhi(t4.x); DST[dkt][8 * hx + 2] = bflo(t4.y); DST[dkt][8 * hx + 3] = bfhi(t4.y); \
            DST[dkt][8 * hx + 4] = bflo(t4.z); DST[dkt][8 * hx + 5] = bfhi(t4.z); DST[dkt][8 * hx + 6] = bflo(t4.w); DST[dkt][8 * hx + 7] = bfhi(t4.w); } } while (0)
        if (sc > 0) { const bf16* dsu = DS + (size_t)(u - sc) * 32768 + lo_; G2_LOAD(cur, dsu); }
        for (int cp = 0; cp < sc; ++cp) {
            const int up = u - sc + cp; const float* dcu = DECG + up * 128 + 4 * h;
            f32x16 nxt[4];
            asm volatile("" : "+v"(lo_));
            if (cp + 1 < sc) { const bf16* dsn = DS + (size_t)(up + 1) * 32768 + lo_; G2_LOAD(nxt, dsn); }
            else {
#pragma unroll
                for (int dkt = 0; dkt < 4; ++dkt)
#pragma unroll
                    for (int r = 0; r < 16; ++r) nxt[dkt][r] = 0.f; }
#pragma unroll
            for (int dkt = 0; dkt < 4; ++dkt)
#pragma unroll
                for (int r4 = 0; r4 < 4; ++r4) { const f32x4 d4 = *(const f32x4*)(dcu + 32 * dkt + 8 * r4);
#pragma unroll
                    for (int e = 0; e < 4; ++e) { S[dkt][4 * r4 + e] = d4[e] * S[dkt][4 * r4 + e] + cur[dkt][4 * r4 + e]; cur[dkt][4 * r4 + e] = nxt[dkt][4 * r4 + e]; } }
        }
#undef G2_LOAD
        bf16x8_t sf[4][2];
#pragma unroll
        for (int dkt = 0; dkt < 4; ++dkt)
#pragma unroll
            for (int s2 = 0; s2 < 2; ++s2) { float p8[8];
#pragma unroll
                for (int e = 0; e < 8; ++e) p8[e] = S[dkt][8 * s2 + e];
                sf[dkt][s2] = packf8(p8); }
        f32x4 gv[4];
#pragma unroll
        for (int rg = 0; rg < 4; ++rg) gv[rg] = *(const f32x4*)(og + hh * 256 + 32 * w + 4 * h + 8 * rg);
        LAS unsigned char* GQ = F.lds + 8192; LAS unsigned char* GO = F.lds + 24576; LAS unsigned char* GR = F.lds + 57344;
#pragma unroll 1
        for (int qtr = 0; qtr < 4; ++qtr) {
            const size_t tokQ = (size_t)(T0 + 64 * qtr);
            int tid = F.tid; asm volatile("" : "+v"(tid));
            { v4u qv[2], ov[4], rv[4];
              const bf16* qb_ = QG + tokQ * 512 + hh * 128; const bf16* ob_ = CAT + tokQ * 1024 + hh * 256; const bf16* rb_ = PROJ + tokQ * OD_IN + 2048 + hh * 256;
#pragma unroll
              for (int i = 0; i < 2; ++i) { const int c = tid + 512 * i, row = c >> 4, ch = c & 15; qv[i] = *(const v4u*)(qb_ + (unsigned)(row * 512 + ch * 8)); }
#pragma unroll
              for (int i = 0; i < 4; ++i) { const int c = tid + 512 * i, row = c >> 5, ch = c & 31; ov[i] = *(const v4u*)(ob_ + (unsigned)(row * 1024 + ch * 8)); rv[i] = *(const v4u*)(rb_ + (unsigned)(row * OD_IN + ch * 8)); }
#pragma unroll
              for (int i = 0; i < 2; ++i) { const int c = tid + 512 * i, row = c >> 4, ch = c & 15; *(LAS v4u*)(GQ + row * 256 + ((ch ^ (row & 15)) << 4)) = qv[i]; }
#pragma unroll
              for (int i = 0; i < 4; ++i) { const int c = tid + 512 * i, row = c >> 5, ch = c & 31; *(LAS v4u*)(GO + row * 512 + ((ch ^ (row & 31)) << 4)) = ov[i]; *(LAS v4u*)(GR + row * 512 + ((ch ^ (row & 31)) << 4)) = rv[i]; } }
            __syncthreads();
            f32x16 o[2];
#pragma unroll
            for (int it = 0; it < 2; ++it) {
                const int row = 32 * it + r32;
#pragma unroll
                for (int r = 0; r < 16; ++r) o[it][r] = 0.f;
                if (sc > 0) {
#pragma unroll
                    for (int dkt = 0; dkt < 4; ++dkt)
#pragma unroll
                        for (int s2 = 0; s2 < 2; ++s2) { const int chk = 4 * dkt + 2 * s2;
                            const s16x4_t q0 = *(const LAS s16x4_t*)(GQ + row * 256 + ((chk ^ (row & 15)) << 4) + 8 * h);
                            const s16x4_t q1 = *(const LAS s16x4_t*)(GQ + row * 256 + (((chk + 1) ^ (row & 15)) << 4) + 8 * h);
                            o[it] = __builtin_amdgcn_mfma_f32_32x32x16_bf16(sf[dkt][s2], cat44(q0, q1), o[it], 0, 0, 0); }
                }
                float q = 0.f;
#pragma unroll
                for (int rg = 0; rg < 4; ++rg) { const v2u ow = *(const LAS v2u*)(GO + row * 512 + (((4 * w + rg) ^ (row & 31)) << 4) + 8 * h);
                    o[it][4 * rg] += bflo(ow.x); o[it][4 * rg + 1] += bfhi(ow.x); o[it][4 * rg + 2] += bflo(ow.y); o[it][4 * rg + 3] += bfhi(ow.y); }
#pragma unroll
                for (int r = 0; r < 16; ++r) q += o[it][r] * o[it][r];
                q += __shfl_xor(q, 32);
                if (h == 0) red[w * 64 + row] = q;
            }
            __syncthreads();
#pragma unroll
            for (int it = 0; it < 2; ++it) {
                const int row = 32 * it + r32; float tot = 0.f;
#pragma unroll
                for (int w2_ = 0; w2_ < 8; ++w2_) tot += red[w2_ * 64 + row];
                const float rn = __builtin_amdgcn_rsqf(tot * (1.0f / 256.0f) + EPSF);
#pragma unroll
                for (int rg = 0; rg < 4; ++rg) {
                    const unsigned a = (unsigned)(row * 512 + (((4 * w + rg) ^ (row & 31)) << 4) + 8 * h);
                    const v2u rw = *(const LAS v2u*)(GR + a);
                    const float r0 = bflo(rw.x), r1 = bfhi(rw.x), r2 = bflo(rw.y), r3 = bfhi(rw.y);
                    const float v0 = o[it][4 * rg] * rn * gv[rg][0] * (r0 * __builtin_amdgcn_rcpf(1.0f + __expf(-r0))), v1 = o[it][4 * rg + 1] * rn * gv[rg][1] * (r1 * __builtin_amdgcn_rcpf(1.0f + __expf(-r1)));
                    const float v2 = o[it][4 * rg + 2] * rn * gv[rg][2] * (r2 * __builtin_amdgcn_rcpf(1.0f + __expf(-r2))), v3 = o[it][4 * rg + 3] * rn * gv[rg][3] * (r3 * __builtin_amdgcn_rcpf(1.0f + __expf(-r3)));
                    v2u wv; wv.x = pg8::cvt_pk_bf16(v0, v1); wv.y = pg8::cvt_pk_bf16(v2, v3); *(LAS v2u*)(GO + a) = wv;
                }
            }
            __syncthreads();
#pragma unroll
            for (int i = 0; i < 4; ++i) { const int c = tid + 512 * i, row = c >> 5, ch = c & 31; *(v4u*)(CAT + tokQ * 1024 + hh * 256 + (unsigned)(row * 1024 + ch * 8)) = *(const LAS v4u*)(GO + row * 512 + ((ch ^ (row & 31)) << 4)); }
            __syncthreads();
        }
    }
}

#define XB_TMO      128
#define XB_XCNT(j)  (256  + 64 * (j))
#define XB_XSUB(j)  (1280 + 64 * (j))
#define XB_XGEN(j)  (2304 + 64 * (j))
#define XB_TOP      3328
#define XB_TOPGEN   3392
#define XCD_BAR_WORDS 3456
#define WCNT_WORD 51200
#define XB_SPIN_CAP (1u << 18)
__device__ __forceinline__ unsigned xb_ld(unsigned* p)              { return __hip_atomic_load(p, __ATOMIC_RELAXED, __HIP_MEMORY_SCOPE_AGENT); }
__device__ __forceinline__ unsigned xb_add(unsigned* p, unsigned v) { return __hip_atomic_fetch_add(p, v, __ATOMIC_RELAXED, __HIP_MEMORY_SCOPE_AGENT); }
__device__ __forceinline__ unsigned xb_xcc_id() { return (unsigned)__builtin_amdgcn_s_getreg((3 << 11) | 20) & 0xFu; }
#define XB_SPIN(cond, bar) do { unsigned _sp = 0; while (cond) { __builtin_amdgcn_s_sleep(1); \
    if ((++_sp & 255u) == 0u) { if (xb_ld(&(bar)[XB_TMO])) break; if (_sp > XB_SPIN_CAP) { atomicAdd(&(bar)[XB_TMO], 1u); break; } } } } while (0)
struct XcdBarrier { unsigned* bar; unsigned x; volatile LAS unsigned* st; unsigned G; bool wave0; };
__device__ __forceinline__ XcdBarrier xcd_barrier_post(unsigned* bar, volatile LAS unsigned* st, unsigned G) {
    XcdBarrier b; b.bar = bar; b.x = xb_xcc_id(); b.st = st; b.G = G; b.wave0 = (__builtin_amdgcn_readfirstlane(threadIdx.x >> 6) == 0);
    if (threadIdx.x == 0) (void)xb_add(&bar[XB_XCNT(b.x)], 1u);
    return b;
}
__device__ __forceinline__ void xcd_barrier_complete(unsigned* bar, unsigned x, unsigned G, unsigned& nloc, unsigned& nx) {
    unsigned sum, cnt, mine, sp = 0u;
    for (;;) {
        sum = 0u; cnt = 0u; mine = 0u;
#pragma unroll
        for (unsigned j = 0; j < 16; ++j) { const unsigned c = xb_ld(&bar[XB_XCNT(j)]); sum += c; cnt += (c > 0u) ? 1u : 0u; mine = (j == x) ? c : mine; }
        if (sum == G) break;
        __builtin_amdgcn_s_sleep(1);
        if ((++sp & 255u) == 0u) { if (xb_ld(&bar[XB_TMO])) break; if (sp > XB_SPIN_CAP) { atomicAdd(&bar[XB_TMO], 1u); break; } }
    }
    nloc = mine > 0u ? mine : 1u; nx = cnt > 0u ? cnt : 1u;
}
__device__ __forceinline__ void xcd_barrier(const XcdBarrier& b, const bool full = true) {
    asm volatile("s_waitcnt vmcnt(0)" ::: "memory");
    __syncthreads();
    if (b.wave0 && hw_lane() == 0) {
        unsigned* bar = b.bar;
        __builtin_amdgcn_s_waitcnt(0);
        unsigned nloc = b.st[0], nx = b.st[1];
        if (nloc == 0u) { xcd_barrier_complete(bar, b.x, b.G, nloc, nx); b.st[0] = nloc; b.st[1] = nx; }
        const unsigned old = xb_add(&bar[XB_XSUB(b.x)], 1u);
        const unsigned gen = old / nloc;
        if (old + 1u == (gen + 1u) * nloc) {
            if (full || nx > 1u) {
                __builtin_amdgcn_fence(__ATOMIC_RELEASE, "agent");
                asm volatile("s_waitcnt vmcnt(0)" ::: "memory");
            }
            if (nx > 1u) {
            const unsigned og = xb_add(&bar[XB_TOP], 1u);
            const unsigned tg = og / nx;
            if (og + 1u == (tg + 1u) * nx) xb_add(&bar[XB_TOPGEN], 1u);
            else XB_SPIN(xb_ld(&bar[XB_TOPGEN]) == tg, bar);
            }
            xb_add(&bar[XB_XGEN(b.x)], 1u);
            __builtin_amdgcn_fence(__ATOMIC_ACQUIRE, "agent");
            asm volatile("s_waitcnt vmcnt(0)" ::: "memory");
        } else {
            XB_SPIN(xb_ld(&bar[XB_XGEN(b.x)]) == gen, bar);
            __builtin_amdgcn_fence(__ATOMIC_ACQUIRE, "agent");
            asm volatile("s_waitcnt vmcnt(0)" ::: "memory");
        }
    }
    __syncthreads();
}


__global__ void __launch_bounds__(NWAVES * 64, 2) mk_fwd(Args args) {
    extern __shared__ __attribute__((aligned(16))) unsigned char lds[];
    Frame F;
    F.lds = (LAS unsigned char*)lds;
    F.tid = threadIdx.x; F.lane = F.tid & 63; F.wave = __builtin_amdgcn_readfirstlane(F.tid >> 6);
    F.G = gridDim.x; { const int bx = blockIdx.x; F.vcu = (F.G % 8 == 0) ? (bx % 8) * (F.G / 8) + bx / 8 : bx; }
    F.kp = (kargp_t)__builtin_amdgcn_kernarg_segment_ptr();
    if (threadIdx.x < 64) ((LAS unsigned*)(F.lds + MISC_OFF))[threadIdx.x] = 0u;
    __syncthreads();
    { const XcdBarrier g0 = xcd_barrier_post((unsigned*)F.wsb(), (volatile LAS unsigned*)(F.lds + MISC_OFF), gridDim.x); (void)g0;
      if (gridDim.x == 256) { const XcdBarrier b0 = xcd_barrier_post((unsigned*)F.wsb() + (1 + (blockIdx.x & 7)) * XCD_BAR_WORDS, (volatile LAS unsigned*)(F.lds + MISC_OFF + 16), 32u); (void)b0; } }
#define GBAR() (XcdBarrier{(unsigned*)F.wsb(), xb_xcc_id(), (volatile LAS unsigned*)(F.lds + MISC_OFF), gridDim.x, F.wave == 0})
#define BBAR() (gridDim.x == 256 ? XcdBarrier{(unsigned*)F.wsb() + (1 + (blockIdx.x & 7)) * XCD_BAR_WORDS, xb_xcc_id(), (volatile LAS unsigned*)(F.lds + MISC_OFF + 16), 32u, F.wave == 0} : GBAR())

#define IN_PH (F.fresh(), true)
#define SEAM() do { xcd_barrier(GBAR()); } while (0)
#define SEAMB() do { xcd_barrier(BBAR(), false); } while (0)
#define SEAMBF() do { xcd_barrier(BBAR(), true); } while (0)
    const int NOMOD = 1 << 30;

    if (IN_PH) p0_prologue(F);
    SEAM();
    for (int l = 0; l < DEPTH; ++l) {
        const int li = l >> 1;
        if (F.G == 256 && l > 0) {
            if (F.wave == 0 && hw_lane() == 0) { unsigned* wc_ = (unsigned*)F.wsb() + WCNT_WORD + 16 * l; XB_SPIN(xb_ld(wc_) < 264u, (unsigned*)F.wsb());
                                                 __builtin_amdgcn_fence(__ATOMIC_ACQUIRE, "agent"); asm volatile("s_waitcnt vmcnt(0)" ::: "memory"); }
            __syncthreads();
        }
        if ((l & 1) == 0) {
            if (IN_PH) {
                pg8::Gemm g{F_XB, F_W + W_EVIN + li * SZ_EVIN, M, EV_IN, D, 256, 32, 64, NOMOD, 0, 0xFEDCBA5476983210ull};
                pg8::StaticOrder S; S.init(M, EV_IN, F.G, (int)blockIdx.x);

                pg8::EpiEven E{F_SS, F_ROPE, F.inf(I_EV_Q_GAIN) + li * 64, F.inf(I_EV_K_GAIN) + li * 64, F.inf(I_EV_LN_G) + li * 512, F.inf(I_EV_LN_B) + li * 512,
                               F_RA, F_RA + 8 * Mi, F_RA + 16 * Mi, F_RA + 24 * Mi, F_RA + 32 * Mi, F_KMP};
                pg8::gemm_phase<pg8::EpiEven, pg8::StaticOrder, true, true, true>(F.lds, g, S, E, F.wave);
            }
            if (IN_PH) {
                pg8::Gemm g{F_MEMB, F_W + W_XKV, 4 * MM, 2 * D, D, 256, 32, 64, MM / 256, (size_t)2 * Mi * 2, 0xFEDCBA9876543210ull};
                pg8::MemKVOrder S{F.G == 256 ? ((int)blockIdx.x >= 128 ? (int)blockIdx.x - 128 : 128) : (int)blockIdx.x, F.G == 256 ? 128 : F.G, l};
                pg8::EpiMemKV E{F_KXN, F_VX, F_SSM, F.inf(I_XA_K_GAIN), F.inf(I_XA_Q_GAIN), (LAS float*)(F.lds + RING_BYTES)};
                pg8::gemm_phase<pg8::EpiMemKV, pg8::MemKVOrder, true>(F.lds, g, S, E, F.wave);
            }
            SEAMB();
            if (IN_PH) { moba_mfma(F); __syncthreads(); gmlp_mfma(F, li); }
            SEAMB();
            if (IN_PH) {
                pg8::Gemm g{F_CAT, F_W + W_EVOUT + li * Mi, M, D, D, 256, 32, 64, NOMOD, 0, 0xFEDCBA9876543210ull};
                pg8::StaticOrder S; S.init(M, D, F.G, (int)blockIdx.x);
                if (l == 0) { pg8::EpiResid<true, false> E{F_X, nullptr, F_XB, F_SS}; pg8::gemm_phase<pg8::EpiResid<true, false>, pg8::StaticOrder, true>(F.lds, g, S, E, F.wave); }
                else { pg8::EpiResid<false, false> E{nullptr, nullptr, F_XB, F_SS}; pg8::gemm_phase<pg8::EpiResid<false, false>, pg8::StaticOrder, true>(F.lds, g, S, E, F.wave); }
            }
            SEAMB();
        } else {
            if (IN_PH) {
                pg8::Gemm g{F_XB, F_W + W_ODIN + li * SZ_ODIN, M, OD_IN, D, 256, 32, 64, NOMOD, 0, 0xFEDCBA9876543210ull};
                pg8::StaticOrder S; S.init(M, OD_IN, F.G, (int)blockIdx.x);
                pg8::EpiStore E{F_RA, OD_IN, F_SS, -1, 512, 0.08838834764831845f};
                pg8::gemm_phase<pg8::EpiStore, pg8::StaticOrder, true, true>(F.lds, g, S, E, F.wave, F_SS);
                gate_t16(F, l, li);
            }
            SEAMB();
            if (IN_PH) gla_g1(F, li);
            SEAMB();
            if (IN_PH) gla_g2(F, li);
            SEAMB();
            if (IN_PH) {
                pg8::Gemm g{F_CAT, F_W + W_ODOUT + li * Mi, M, D, D, 256, 32, 64, NOMOD, 0, 0xFEDCBA9876543210ull};
                pg8::StaticOrder S; S.init(M, D, F.G, (int)blockIdx.x);
                pg8::EpiResid<false, false> E{nullptr, nullptr, F_XB, F_SS};
                pg8::gemm_phase<pg8::EpiResid<false, false>, pg8::StaticOrder, true>(F.lds, g, S, E, F.wave);
            }
            SEAMB();
        }
        if (IN_PH) {
            pg8::Gemm g{F_XB, F_W + W_XQ + l * Mi, M, D, D, 256, 32, 64, NOMOD, 0, 0xFEDCBA9876543210ull};
            pg8::StaticOrder S; S.init(M, D, F.G, (int)blockIdx.x);
            pg8::EpiStoreQT E{F_RA, F_SS};
            pg8::gemm_phase<pg8::EpiStoreQT, pg8::StaticOrder, true, true>(F.lds, g, S, E, F.wave, F_SS);
            asm volatile("s_waitcnt vmcnt(0)" ::: "memory"); __syncthreads();
            if (F.wave == 0) { __builtin_amdgcn_fence(__ATOMIC_ACQUIRE, "agent"); asm volatile("s_waitcnt vmcnt(0)" ::: "memory"); }
            __syncthreads();
            xattn_mfma(F, l, S);
        }
        SEAMB();
        if (IN_PH) {
            pg8::Gemm g{F_CAT, F_W + W_XO + l * Mi, M, D, D, 256, 32, 64, NOMOD, 0, 0xFEDCBA9876543210ull};
            pg8::StaticOrder S; S.init(M, D, F.G, (int)blockIdx.x);
            pg8::EpiResid<false, false> E{nullptr, nullptr, F_XB, F_SS};
            pg8::gemm_phase<pg8::EpiResid<false, false>, pg8::StaticOrder, true>(F.lds, g, S, E, F.wave);
        }
        SEAMB();
        if (IN_PH) {
            pg8::Gemm g{F_XB, F_W + W_GU + l * SZ_GU, M, 2 * DFF, D, 128, DFF, 32, NOMOD, 0, 0xFEDCBA9876543210ull};
            pg8::StaticOrder S; S.init(M, 2 * DFF, F.G, (int)blockIdx.x);
            pg8::EpiSwiglu E{F_RA + 16 * Mi, DFF, F_SS};
            pg8::gemm_phase<pg8::EpiSwiglu, pg8::StaticOrder, true, true>(F.lds, g, S, E, F.wave, F_SS);
            if (F.G == 256 && l + 1 < DEPTH && (int)blockIdx.x >= 128) {
                __syncthreads();
                const int f0 = p0_layer_first(l + 1);
                p0_convert(F, f0 + ((int)blockIdx.x - 128) * NWAVES + F.wave, 128 * NWAVES, f0 + (((l + 1) & 1) ? 7296 : 7040));
            }
        }
        if (l + 1 < DEPTH) SEAMBF(); else SEAMB();
        if (F.G == 256 && l + 1 < DEPTH && blockIdx.x < 8 && F.wave == 0 && hw_lane() == 0) (void)xb_add((unsigned*)F.wsb() + WCNT_WORD + 16 * (l + 1), 1u);
        if (IN_PH) {
            pg8::Gemm g{F_RA + 16 * Mi, F_W + W_DN + l * SZ_DN, M, D, DFF, 256, 32, 64, NOMOD, 0, 0xFEDCBA9876543210ull};
            pg8::StaticOrder S; S.init(M, D, F.G, (int)blockIdx.x);
            if (l == DEPTH - 1) { pg8::EpiResid<false, true> E{nullptr, F_OUT, F_XB, F_SS}; pg8::gemm_phase<pg8::EpiResid<false, true>, pg8::StaticOrder, true>(F.lds, g, S, E, F.wave); }
            else { pg8::EpiResid<false, false> E{nullptr, nullptr, F_XB, F_SS}; pg8::gemm_phase<pg8::EpiResid<false, false>, pg8::StaticOrder, true>(F.lds, g, S, E, F.wave); }
        }
        if (l + 1 < DEPTH) {
            if (F.wave == 0 && hw_lane() == 0) { unsigned* fp_ = (unsigned*)F.wsb() + WCNT_WORD + 16 * (l + 1); asm volatile("" : "+s"(fp_)); (void)xb_add(fp_, 1u); }
            SEAMB();
        }
    }
#undef IN_PH
#undef SEAM
#undef SEAMB
#undef SEAMBF
#undef GBAR
#undef BBAR
}

extern "C" void kernel_launch(void* const* d_in, const int* in_sizes, int n_in, void* d_out, int out_size, void* d_ws, size_t ws_size, hipStream_t stream) {
    static int grid = 0;
    if (grid == 0) {
        if (n_in != 28 || out_size != M * D || ws_size < WS_END) { fprintf(stderr, "kernel_launch: unexpected problem (n_in %d out %d ws %zu)\n", n_in, out_size, ws_size); grid = -1; return; }
        int dev = 0, cus = 0, per_cu = 0;
        hipGetDevice(&dev); hipDeviceGetAttribute(&cus, hipDeviceAttributeMultiprocessorCount, dev);
        if (hipFuncSetAttribute((const void*)mk_fwd, hipFuncAttributeMaxDynamicSharedMemorySize, LDS_BYTES) != hipSuccess) { fprintf(stderr, "kernel_launch: hipFuncSetAttribute failed\n"); grid = -1; return; }
        hipOccupancyMaxActiveBlocksPerMultiprocessor(&per_cu, (const void*)mk_fwd, NWAVES * 64, LDS_BYTES);
        (void)hipGetLastError();
        if (per_cu < 1) { fprintf(stderr, "kernel_launch: occupancy query says %d blocks per CU\n", per_cu); }
        grid = cus;
    }
    if (grid < 0) return;
    if (hipMemsetAsync(d_ws, 0, 262144, stream) != hipSuccess) { fprintf(stderr, "kernel_launch: hipMemsetAsync failed\n"); return; }
    Args a{};
    for (int i = 0; i < 28; ++i) a.in[i] = d_in[i];
    a.out = (float*)d_out; a.ws = (unsigned char*)d_ws;
    void* kargs[] = {&a};
    hipError_t e = hipLaunchCooperativeKernel((const void*)mk_fwd, dim3(grid), dim3(NWAVES * 64), kargs, LDS_BYTES, stream);
    if (e != hipSuccess) fprintf(stderr, "cooperative launch failed: %s (grid %d)\n", hipGetErrorString(e), grid);
}
```
